# Optimizing an MI355X kernel written in HIP

```python
import math
import jax, jax.numpy as jnp
from jax import lax
import numpy as np

D_MODEL = 1024
BATCH = 8
SEQ = 4096
DEPTH = 1

CHUNK = 64
PLE_DIM = 256
MIX_WIDTH = D_MODEL
SSM_WIDTH = MIX_WIDTH // 2
POOL_WIDTH = MIX_WIDTH - SSM_WIDTH
SSM_GROUP = 16
SSM_GROUPS = SSM_WIDTH // SSM_GROUP
SSM_STATE = 64
POOL_WINDOWS = (2, 4, 8, 16)
POOL_GROUPS = len(POOL_WINDOWS)
POOL_GROUP_WIDTH = POOL_WIDTH // POOL_GROUPS
POOL_PAD = max(POOL_WINDOWS)
D_FF = 2816
FFN_RES = 0.5
EPS = 1e-6
DT_MIN = 1e-3
DT_MAX = 1e-1

kernel_name = 'hymba_s5_pool_macaron_block'


def rmsnorm(x, g):
    xf = x.astype(jnp.float32)
    y = xf * lax.rsqrt(jnp.mean(xf * xf, axis=-1, keepdims=True) + EPS)
    return (y * g.astype(jnp.float32)).astype(x.dtype)


def swiglu(x, w1, w3, w2):
    return (jax.nn.silu(x @ w1) * (x @ w3)) @ w2


def _complex_linear_combine(e1, e2):
    a1r, a1i, b1r, b1i = e1
    a2r, a2i, b2r, b2i = e2
    return (a2r * a1r - a2i * a1i,
            a2r * a1i + a2i * a1r,
            a2r * b1r - a2i * b1i + b2r,
            a2r * b1i + a2i * b1r + b2i)


def s5_mixer(u, a_re, a_im, log_dt, b_re, b_im, c_re, c_im, d_skip, w_glu, b_glu):
    f32 = jnp.float32
    bsz, seqlen, _ = u.shape
    uf = u.astype(f32)
    ug = uf.reshape(bsz, seqlen, SSM_GROUPS, SSM_GROUP)
    dt = jnp.exp(log_dt.astype(f32))[:, None]
    lam_r = a_re.astype(f32)
    lam_i = a_im.astype(f32)
    mag = jnp.exp(lam_r * dt)
    abar_r = mag * jnp.cos(lam_i * dt)
    abar_i = mag * jnp.sin(lam_i * dt)
    den = lam_r * lam_r + lam_i * lam_i
    nr = abar_r - 1.0
    f_r = (nr * lam_r + abar_i * lam_i) / den
    f_i = (abar_i * lam_r - nr * lam_i) / den
    br = b_re.astype(f32)
    bi = b_im.astype(f32)
    bbar_r = f_r[..., None] * br - f_i[..., None] * bi
    bbar_i = f_r[..., None] * bi + f_i[..., None] * br
    bu_r = jnp.einsum('blgp,gnp->blgn', ug, bbar_r)
    bu_i = jnp.einsum('blgp,gnp->blgn', ug, bbar_i)
    ones_t = jnp.ones((1, seqlen, 1, 1), f32)
    a_seq_r = abar_r[None, None] * ones_t
    a_seq_i = abar_i[None, None] * ones_t
    _, _, s_r, s_i = lax.associative_scan(
        _complex_linear_combine, (a_seq_r, a_seq_i, bu_r, bu_i), axis=1)
    y = (jnp.einsum('gpn,blgn->blgp', c_re.astype(f32), s_r)
         - jnp.einsum('gpn,blgn->blgp', c_im.astype(f32), s_i))
    y = y.reshape(bsz, seqlen, SSM_WIDTH) + d_skip.astype(f32) * uf
    y = jax.nn.gelu(y)
    y = y * jax.nn.sigmoid(y @ w_glu.astype(f32) + b_glu.astype(f32))
    return y.astype(u.dtype)


def pool_mixer(v, w_pool, pool_scale):
    f32 = jnp.float32
    bsz, seqlen, _ = v.shape
    vg = v.astype(f32).reshape(bsz, seqlen, POOL_GROUPS, POOL_GROUP_WIDTH)
    csum = jnp.cumsum(jnp.pad(vg, ((0, 0), (POOL_PAD, 0), (0, 0), (0, 0))), axis=1)
    t = jnp.arange(seqlen)
    outs = []
    for gi, w in enumerate(POOL_WINDOWS):
        win_sum = csum[:, POOL_PAD:, gi] - csum[:, POOL_PAD - w:POOL_PAD - w + seqlen, gi]
        count = jnp.minimum(t + 1, w).astype(f32)[None, :, None]
        outs.append(win_sum / count - vg[:, :, gi])
    pooled = jnp.stack(outs, axis=2)
    y = jnp.einsum('blgc,gcd->blgd', pooled, w_pool.astype(f32))
    y = y.reshape(bsz, seqlen, POOL_WIDTH) * pool_scale.astype(f32)
    return y.astype(v.dtype)


def setup_inputs(seed: int = 0) -> dict:
    key = jax.random.key(seed)
    ks = iter(jax.random.split(key, 48))
    f32 = jnp.float32

    def nrm(shape, scale):
        return jax.random.normal(next(ks), shape, f32) * scale

    def gain(shape):
        return 1.0 + nrm(shape, 0.02)

    x = nrm((BATCH, SEQ, D_MODEL), 1.0)
    p = nrm((DEPTH, BATCH, SEQ, PLE_DIM), 1.0)
    ffn1_norm = gain((DEPTH, D_MODEL))
    ffn1_w1 = nrm((DEPTH, D_MODEL, D_FF), D_MODEL ** -0.5)
    ffn1_w3 = nrm((DEPTH, D_MODEL, D_FF), D_MODEL ** -0.5)
    ffn1_w2 = nrm((DEPTH, D_FF, D_MODEL), D_FF ** -0.5)
    mix_norm = gain((DEPTH, D_MODEL))
    w_in = nrm((DEPTH, D_MODEL, MIX_WIDTH), D_MODEL ** -0.5)
    a_re = -0.5 + nrm((DEPTH, SSM_GROUPS, SSM_STATE), 0.01)
    a_im = math.pi * jnp.arange(SSM_STATE, dtype=f32)[None, None, :] + nrm((DEPTH, SSM_GROUPS, SSM_STATE), 0.01)
    log_dt = jax.random.uniform(next(ks), (DEPTH, SSM_GROUPS), f32, math.log(DT_MIN), math.log(DT_MAX))
    b_re = nrm((DEPTH, SSM_GROUPS, SSM_STATE, SSM_GROUP), (2 * SSM_GROUP) ** -0.5)
    b_im = nrm((DEPTH, SSM_GROUPS, SSM_STATE, SSM_GROUP), (2 * SSM_GROUP) ** -0.5)
    c_re = nrm((DEPTH, SSM_GROUPS, SSM_GROUP, SSM_STATE), (2 * SSM_STATE) ** -0.5)
    c_im = nrm((DEPTH, SSM_GROUPS, SSM_GROUP, SSM_STATE), (2 * SSM_STATE) ** -0.5)
    d_skip = nrm((DEPTH, SSM_WIDTH), 1.0)
    w_glu = nrm((DEPTH, SSM_WIDTH, SSM_WIDTH), SSM_WIDTH ** -0.5)
    b_glu = nrm((DEPTH, SSM_WIDTH), 0.01)
    w_pool = nrm((DEPTH, POOL_GROUPS, POOL_GROUP_WIDTH, POOL_GROUP_WIDTH), POOL_GROUP_WIDTH ** -0.5)
    pool_scale = gain((DEPTH, POOL_WIDTH))
    ssm_out_norm = gain((DEPTH, SSM_WIDTH))
    pool_out_norm = gain((DEPTH, POOL_WIDTH))
    w_out = nrm((DEPTH, MIX_WIDTH, D_MODEL), MIX_WIDTH ** -0.5)
    ffn2_norm = gain((DEPTH, D_MODEL))
    ffn2_w1 = nrm((DEPTH, D_MODEL, D_FF), D_MODEL ** -0.5)
    ffn2_w3 = nrm((DEPTH, D_MODEL, D_FF), D_MODEL ** -0.5)
    ffn2_w2 = nrm((DEPTH, D_FF, D_MODEL), D_FF ** -0.5)
    ple_gate_norm = gain((DEPTH, D_MODEL))
    w_ple_gate = nrm((DEPTH, D_MODEL, D_MODEL), D_MODEL ** -0.5)
    w_ple_proj = nrm((DEPTH, PLE_DIM, D_MODEL), PLE_DIM ** -0.5)
    ple_norm = gain((DEPTH, D_MODEL))
    final_norm = gain((D_MODEL,))
    return {'x': x, 'p': p,
            'ffn1_norm': ffn1_norm, 'ffn1_w1': ffn1_w1, 'ffn1_w3': ffn1_w3, 'ffn1_w2': ffn1_w2,
            'mix_norm': mix_norm, 'w_in': w_in,
            'a_re': a_re, 'a_im': a_im, 'log_dt': log_dt, 'b_re': b_re, 'b_im': b_im,
            'c_re': c_re, 'c_im': c_im, 'd_skip': d_skip, 'w_glu': w_glu, 'b_glu': b_glu,
            'w_pool': w_pool, 'pool_scale': pool_scale,
            'ssm_out_norm': ssm_out_norm, 'pool_out_norm': pool_out_norm, 'w_out': w_out,
            'ffn2_norm': ffn2_norm, 'ffn2_w1': ffn2_w1, 'ffn2_w3': ffn2_w3, 'ffn2_w2': ffn2_w2,
            'ple_gate_norm': ple_gate_norm, 'w_ple_gate': w_ple_gate, 'w_ple_proj': w_ple_proj,
            'ple_norm': ple_norm, 'final_norm': final_norm}


def reference(x, p, ffn1_norm, ffn1_w1, ffn1_w3, ffn1_w2, mix_norm, w_in,
              a_re, a_im, log_dt, b_re, b_im, c_re, c_im, d_skip, w_glu, b_glu,
              w_pool, pool_scale, ssm_out_norm, pool_out_norm, w_out,
              ffn2_norm, ffn2_w1, ffn2_w3, ffn2_w2,
              ple_gate_norm, w_ple_gate, w_ple_proj, ple_norm, final_norm):
    h = x
    for i in range(DEPTH):
        h = h + FFN_RES * swiglu(rmsnorm(h, ffn1_norm[i]), ffn1_w1[i], ffn1_w3[i], ffn1_w2[i])
        z = rmsnorm(h, mix_norm[i]) @ w_in[i]
        y_ssm = s5_mixer(z[..., :SSM_WIDTH], a_re[i], a_im[i], log_dt[i], b_re[i], b_im[i],
                         c_re[i], c_im[i], d_skip[i], w_glu[i], b_glu[i])
        y_pool = pool_mixer(z[..., SSM_WIDTH:], w_pool[i], pool_scale[i])
        y = jnp.concatenate([rmsnorm(y_ssm, ssm_out_norm[i]),
                             rmsnorm(y_pool, pool_out_norm[i])], axis=-1)
        h = h + y @ w_out[i]
        h = h + FFN_RES * swiglu(rmsnorm(h, ffn2_norm[i]), ffn2_w1[i], ffn2_w3[i], ffn2_w2[i])
        gate = jax.nn.sigmoid(rmsnorm(h, ple_gate_norm[i]) @ w_ple_gate[i])
        emb = rmsnorm(p[i].astype(h.dtype) @ w_ple_proj[i], ple_norm[i])
        h = h + gate * emb
    return rmsnorm(h, final_norm)
```

```cpp
#include <hip/hip_runtime.h>
#include <cstdio>
#include <cstdint>

#ifndef MK_N_LAUNCHES
#define MK_N_LAUNCHES 1
#endif

namespace pg8 {
#define PG8_LAS __attribute__((address_space(3)))
typedef unsigned short bf16_t;
typedef short bf16x8 __attribute__((ext_vector_type(8)));
typedef float f32x4 __attribute__((ext_vector_type(4)));
typedef float f32x2 __attribute__((ext_vector_type(2)));
typedef unsigned u32x4 __attribute__((ext_vector_type(4)));
typedef unsigned u32x2 __attribute__((ext_vector_type(2)));
constexpr int BM = 256, BK = 64, HALF = 128, HTB = HALF * BK * 2, STAGE_BYTES = 8 * HTB, NXCD = 8, WGM = 8;

__host__ __device__ __forceinline__ int lds_byte(int r, int c) { const int st = (r >> 4) * 2 + (c >> 5), rr = r & 15, cc = c & 31, ob = rr * 64 + cc * 2; return st * 1024 + (ob ^ (((ob >> 9) & 1) << 5)); }
__host__ __device__ __forceinline__ void stage_rc(int b, int& R, int& C) { const int st = b / 1024, sb = b % 1024, swz = sb ^ (((sb >> 9) & 1) << 5); R = (st >> 1) * 16 + swz / 64; C = (st & 1) * 32 + (swz % 64) / 2; }
__host__ __device__ __forceinline__ int perm32(int rho) { const int n = rho >> 4, i = rho & 15; return 8 * (i >> 2) + 4 * n + (i & 3); }

struct Unit { int pm, pn; };
struct Gemm { const bf16_t* A; const bf16_t* Bt; int lda, ldb, K; };

struct StaticOrder {
    int nM, nN, nwg, G, c;
    __device__ void init(int M, int N, int G_, int c_) { nM = M / BM; nN = N / BM; nwg = nM * nN; G = G_; c = c_; }
    __device__ bool next(int i, Unit& u) const {
        const long L = (long)i * G + c; if (L >= nwg) return false;
        int wgid = (int)L; { const int q = nwg / NXCD, r = nwg % NXCD, xcd = wgid % NXCD, off = wgid / NXCD; wgid = (xcd < r ? xcd * (q + 1) : r * (q + 1) + (xcd - r) * q) + off; }
        const int nig = WGM * nN, gid = wgid / nig, fm = gid * WGM, gsz = (nM - fm) < WGM ? (nM - fm) : WGM;
        u.pm = fm + ((wgid % nig) % gsz); u.pn = (wgid % nig) / gsz; return true;
    }
};
struct SingleUnit {
    int pm, pn;
    __device__ bool next(int i, Unit& u) const { if (i > 0) return false; u.pm = pm; u.pn = pn; return true; }
};

__device__ __forceinline__ unsigned cvt_pk_bf16(float lo, float hi) { unsigned r; asm volatile("v_cvt_pk_bf16_f32 %0, %1, %2" : "=v"(r) : "v"(lo), "v"(hi)); return r; }
__device__ __forceinline__ float bf_lo(unsigned w) { return __uint_as_float(w << 16); }
__device__ __forceinline__ float bf_hi(unsigned w) { return __uint_as_float(w & 0xffff0000u); }
__device__ __forceinline__ float sigm(float x) { return __builtin_amdgcn_rcpf(1.0f + __expf(-x)); }
constexpr float RMS_EPS = 1e-6f;
template <int NP> __device__ __forceinline__ float row_rstd(const float* ss, int r, float inv_n) {
    float s = 0.f;
    if constexpr (NP == 1) s = ss[r];
    else {
#pragma unroll
        for (int i = 0; i < NP / 4; ++i) { const f32x4 v = *(const f32x4*)(ss + (size_t)r * NP + 4 * i); s += (v[0] + v[1]) + (v[2] + v[3]); }
    }
    return rsqrtf(s * inv_n + RMS_EPS);
}
__device__ __forceinline__ float quad_sum(float q) { q += __shfl_xor(q, 16); q += __shfl_xor(q, 32); return q; }

#define EPI_ROW_LOOP _Pragma("unroll") for (int ai = 0; ai < 2; ++ai) _Pragma("unroll") for (int m = 0; m < 4; ++m)
#define EPI_ROW (u.pm * BM + ai * HALF + wr * 64 + m * 16 + fr)

template <int NP> struct EpiSwiGLU {
    static constexpr bool PERM = true, AFTER_DRAIN = false, MIDSCALE = false;
    bf16_t* O; int ldo; const float* ss; float inv_n;
    __device__ __forceinline__ void operator()(const f32x4 (&acc)[2][2][4][2], const Unit& u, int wr, int wc, int fr, int fq) const {
        const int col0 = u.pn * HALF + wc * 32 + 8 * fq;
        EPI_ROW_LOOP { const int r = EPI_ROW;
            const float rs = row_rstd<NP>(ss, r, inv_n);
            float o[8];
#pragma unroll
            for (int n = 0; n < 2; ++n)
#pragma unroll
                for (int j = 0; j < 4; ++j) { const float a = acc[ai][0][m][n][j] * rs, b = acc[ai][1][m][n][j] * rs; o[4 * n + j] = a * sigm(a) * b; }
            u32x4 w; w.x = cvt_pk_bf16(o[0], o[1]); w.y = cvt_pk_bf16(o[2], o[3]); w.z = cvt_pk_bf16(o[4], o[5]); w.w = cvt_pk_bf16(o[6], o[7]);
            *(u32x4*)(O + (size_t)r * ldo + col0) = w;
        }
    }
    __device__ __forceinline__ void midscale(f32x4 (&)[2][2][4][2], const Unit&, int, int) const {}
};

template <bool MID> struct EpiResid {
    static constexpr bool PERM = false, AFTER_DRAIN = false, MIDSCALE = MID;
    const float* res; float* out; bf16_t* hb; float* ssout; const float* ssmid; float inv_mid;
    __device__ __forceinline__ void operator()(const f32x4 (&acc)[2][2][4][2], const Unit& u, int wr, int wc, int fr, int fq) const {
        const int col0 = u.pn * BM + wc * 32 + 4 * fq;
        EPI_ROW_LOOP { const int r = EPI_ROW;
            const size_t off = (size_t)r * 1024 + col0; float q = 0.f;
#pragma unroll
            for (int bj = 0; bj < 2; ++bj)
#pragma unroll
                for (int n = 0; n < 2; ++n) { const f32x4 rv = *(const f32x4*)(res + off + bj * HALF + n * 16); const f32x4 v = rv + acc[ai][bj][m][n];
                    *(f32x4*)(out + off + bj * HALF + n * 16) = v; u32x2 w; w.x = cvt_pk_bf16(v[0], v[1]); w.y = cvt_pk_bf16(v[2], v[3]);
                    *(u32x2*)(hb + off + bj * HALF + n * 16) = w; q += (v[0] * v[0] + v[1] * v[1]) + (v[2] * v[2] + v[3] * v[3]); }
            q = quad_sum(q);
            if (fq == 0) ssout[(size_t)r * 16 + u.pn * 4 + wc] = q;
        }
    }
    __device__ __forceinline__ void midscale(f32x4 (&acc)[2][2][4][2], const Unit& u, int wr, int fr) const {
        EPI_ROW_LOOP { const int r = EPI_ROW;
            const float rs = row_rstd<8>(ssmid, r, inv_mid);
#pragma unroll
            for (int bj = 0; bj < 2; ++bj)
#pragma unroll
                for (int n = 0; n < 2; ++n) acc[ai][bj][m][n] *= rs;
        }
    }
};

struct EpiWin {
    static constexpr bool PERM = true, AFTER_DRAIN = false, MIDSCALE = false;
    bf16_t* Aext; bf16_t* Q; const float* ss;
    __device__ __forceinline__ void operator()(const f32x4 (&acc)[2][2][4][2], const Unit& u, int wr, int wc, int fr, int fq) const {
        EPI_ROW_LOOP { const int r = EPI_ROW;
            const float rs = row_rstd<16>(ss, r, 1.0f / 1024.0f);
#pragma unroll
            for (int bj = 0; bj < 2; ++bj) {
                const f32x4 v0 = acc[ai][bj][m][0] * rs, v1 = acc[ai][bj][m][1] * rs;
                u32x4 w; w.x = cvt_pk_bf16(v0[0], v0[1]); w.y = cvt_pk_bf16(v0[2], v0[3]); w.z = cvt_pk_bf16(v1[0], v1[1]); w.w = cvt_pk_bf16(v1[2], v1[3]);
                const int c0 = (u.pn & 1) * BM + bj * HALF + wc * 32 + 8 * fq;
                if (u.pn < 2) { const int g = c0 >> 4, q0 = c0 & 15, b = r >> 12, l = r & 4095;
                    *(u32x4*)(Aext + ((size_t)((g * 8 + b) * 256 + (l >> 4))) * 384 + 128 + (l & 15) * 16 + q0) = w; }
                else *(u32x4*)(Q + (size_t)r * 512 + c0) = w;
            }
        }
    }
    __device__ __forceinline__ void midscale(f32x4 (&)[2][2][4][2], const Unit&, int, int) const {}
};

struct EpiGlu {
    static constexpr bool PERM = true, AFTER_DRAIN = false, MIDSCALE = false;
    const bf16_t* Y; bf16_t* A5; const float* bias; float* ssout;
    __device__ __forceinline__ void operator()(const f32x4 (&acc)[2][2][4][2], const Unit& u, int wr, int wc, int fr, int fq) const {
        const int colb = u.pn * BM + wc * 32 + 8 * fq;
        f32x4 bv[2][2];
#pragma unroll
        for (int bj = 0; bj < 2; ++bj)
#pragma unroll
            for (int n = 0; n < 2; ++n) bv[bj][n] = *(const f32x4*)(bias + colb + bj * HALF + 4 * n);
        EPI_ROW_LOOP { const int r = EPI_ROW;
            float q = 0.f;
#pragma unroll
            for (int bj = 0; bj < 2; ++bj) {
                const int c0 = colb + bj * HALF;
                const u32x4 yw = *(const u32x4*)(Y + (size_t)r * 512 + c0);
                const f32x4 g0 = acc[ai][bj][m][0] + bv[bj][0], g1 = acc[ai][bj][m][1] + bv[bj][1];
                float o[8];
                o[0] = bf_lo(yw.x) * sigm(g0[0]); o[1] = bf_hi(yw.x) * sigm(g0[1]); o[2] = bf_lo(yw.y) * sigm(g0[2]); o[3] = bf_hi(yw.y) * sigm(g0[3]);
                o[4] = bf_lo(yw.z) * sigm(g1[0]); o[5] = bf_hi(yw.z) * sigm(g1[1]); o[6] = bf_lo(yw.w) * sigm(g1[2]); o[7] = bf_hi(yw.w) * sigm(g1[3]);
#pragma unroll
                for (int j = 0; j < 8; ++j) q += o[j] * o[j];
                u32x4 w; w.x = cvt_pk_bf16(o[0], o[1]); w.y = cvt_pk_bf16(o[2], o[3]); w.z = cvt_pk_bf16(o[4], o[5]); w.w = cvt_pk_bf16(o[6], o[7]);
                *(u32x4*)(A5 + (size_t)r * 1024 + c0) = w;
            }
            q = quad_sum(q);
            if (fq == 0) ssout[(size_t)r * 8 + u.pn * 4 + wc] = q;
        }
    }
    __device__ __forceinline__ void midscale(f32x4 (&)[2][2][4][2], const Unit&, int, int) const {}
};

struct EpiEmb {
    static constexpr bool PERM = true, AFTER_DRAIN = false, MIDSCALE = false;
    bf16_t* E; float* ssout;
    __device__ __forceinline__ void operator()(const f32x4 (&acc)[2][2][4][2], const Unit& u, int wr, int wc, int fr, int fq) const {
        const int colb = u.pn * BM + wc * 32 + 8 * fq;
        EPI_ROW_LOOP { const int r = EPI_ROW;
            float q = 0.f;
#pragma unroll
            for (int bj = 0; bj < 2; ++bj) {
                const f32x4 v0 = acc[ai][bj][m][0], v1 = acc[ai][bj][m][1];
                q += (v0[0] * v0[0] + v0[1] * v0[1]) + (v0[2] * v0[2] + v0[3] * v0[3]) + (v1[0] * v1[0] + v1[1] * v1[1]) + (v1[2] * v1[2] + v1[3] * v1[3]);
                u32x4 w; w.x = cvt_pk_bf16(v0[0], v0[1]); w.y = cvt_pk_bf16(v0[2], v0[3]); w.z = cvt_pk_bf16(v1[0], v1[1]); w.w = cvt_pk_bf16(v1[2], v1[3]);
                *(u32x4*)(E + (size_t)r * 1024 + colb + bj * HALF) = w;
            }
            q = quad_sum(q);
            if (fq == 0) ssout[(size_t)r * 16 + u.pn * 4 + wc] = q;
        }
    }
    __device__ __forceinline__ void midscale(f32x4 (&)[2][2][4][2], const Unit&, int, int) const {}
};

struct EpiGate {
    static constexpr bool PERM = true, AFTER_DRAIN = false, MIDSCALE = false;
    float* out; const bf16_t* E; const float* ss3; const float* sse; const float* gple; float* ssout;
    __device__ __forceinline__ void operator()(const f32x4 (&acc)[2][2][4][2], const Unit& u, int wr, int wc, int fr, int fq) const {
        const int colb = u.pn * BM + wc * 32 + 8 * fq;
        EPI_ROW_LOOP { const int r = EPI_ROW;
            const float rs3 = row_rstd<16>(ss3, r, 1.0f / 1024.0f), rse = row_rstd<16>(sse, r, 1.0f / 1024.0f);
            float q = 0.f;
#pragma unroll
            for (int bj = 0; bj < 2; ++bj) {
                const int c0 = colb + bj * HALF; const size_t off = (size_t)r * 1024 + c0;
                const u32x4 ew = *(const u32x4*)(E + off);
                const f32x4 gp0 = *(const f32x4*)(gple + c0), gp1 = *(const f32x4*)(gple + c0 + 4);
                const f32x4 h0 = *(const f32x4*)(out + off), h1 = *(const f32x4*)(out + off + 4);
                const f32x4 a0 = acc[ai][bj][m][0] * rs3, a1 = acc[ai][bj][m][1] * rs3;
                f32x4 o0, o1;
                o0[0] = h0[0] + sigm(a0[0]) * (bf_lo(ew.x) * rse * gp0[0]); o0[1] = h0[1] + sigm(a0[1]) * (bf_hi(ew.x) * rse * gp0[1]);
                o0[2] = h0[2] + sigm(a0[2]) * (bf_lo(ew.y) * rse * gp0[2]); o0[3] = h0[3] + sigm(a0[3]) * (bf_hi(ew.y) * rse * gp0[3]);
                o1[0] = h1[0] + sigm(a1[0]) * (bf_lo(ew.z) * rse * gp1[0]); o1[1] = h1[1] + sigm(a1[1]) * (bf_hi(ew.z) * rse * gp1[1]);
                o1[2] = h1[2] + sigm(a1[2]) * (bf_lo(ew.w) * rse * gp1[2]); o1[3] = h1[3] + sigm(a1[3]) * (bf_hi(ew.w) * rse * gp1[3]);
                q += (o0[0] * o0[0] + o0[1] * o0[1]) + (o0[2] * o0[2] + o0[3] * o0[3]) + (o1[0] * o1[0] + o1[1] * o1[1]) + (o1[2] * o1[2] + o1[3] * o1[3]);
                *(f32x4*)(out + off) = o0; *(f32x4*)(out + off + 4) = o1;
            }
            q = quad_sum(q);
            if (fq == 0) ssout[(size_t)r * 16 + u.pn * 4 + wc] = q;
        }
    }
    __device__ __forceinline__ void midscale(f32x4 (&)[2][2][4][2], const Unit&, int, int) const {}
};

struct EpiS5End {
    static constexpr bool PERM = false, AFTER_DRAIN = true, MIDSCALE = false;
    __device__ __forceinline__ void fused(f32x4 (&acc)[2][2][4][2], const Unit&, int wr, int wc, int fr, int fq, PG8_LAS unsigned char* lds, int, int) const {
        PG8_LAS float* El = (PG8_LAS float*)lds;
#pragma unroll
        for (int ai = 0; ai < 2; ++ai)
#pragma unroll
            for (int m = 0; m < 4; ++m) { const int c = ai * HALF + wr * 64 + m * 16 + fr;
#pragma unroll
                for (int n = 0; n < 2; ++n) *(PG8_LAS f32x4*)(El + c * 128 + wc * 32 + n * 16 + 4 * fq) = acc[ai][0][m][n]; }
    }
    __device__ __forceinline__ void midscale(f32x4 (&)[2][2][4][2], const Unit&, int, int) const {}
};

struct EpiS5Out {
    static constexpr bool PERM = true, AFTER_DRAIN = false, MIDSCALE = false;
    const bf16_t* Aext; bf16_t* Y; const float* dskip;
    __device__ __forceinline__ void operator()(const f32x4 (&acc)[2][2][4][2], const Unit& u, int wr, int wc, int fr, int fq) const {
        const int g = u.pn, b = u.pm & 7;
        const int p0 = (8 * fq) & 15;
        const f32x4 d0 = *(const f32x4*)(dskip + g * 16 + p0), d1 = *(const f32x4*)(dskip + g * 16 + p0 + 4);
#pragma unroll
        for (int ai = 0; ai < 2; ++ai)
#pragma unroll
            for (int m = 0; m < 4; ++m) { const int c = ai * HALF + wr * 64 + m * 16 + fr;
#pragma unroll
                for (int bj = 0; bj < 2; ++bj) {
                    const int cl = bj * HALF + wc * 32 + 8 * fq, t = cl >> 4;
                    const u32x4 uw = *(const u32x4*)(Aext + ((size_t)u.pm * 256 + c) * 384 + 128 + cl);
                    float v[8];
                    v[0] = acc[ai][bj][m][0][0] + d0[0] * bf_lo(uw.x); v[1] = acc[ai][bj][m][0][1] + d0[1] * bf_hi(uw.x);
                    v[2] = acc[ai][bj][m][0][2] + d0[2] * bf_lo(uw.y); v[3] = acc[ai][bj][m][0][3] + d0[3] * bf_hi(uw.y);
                    v[4] = acc[ai][bj][m][1][0] + d1[0] * bf_lo(uw.z); v[5] = acc[ai][bj][m][1][1] + d1[1] * bf_hi(uw.z);
                    v[6] = acc[ai][bj][m][1][2] + d1[2] * bf_lo(uw.w); v[7] = acc[ai][bj][m][1][3] + d1[3] * bf_hi(uw.w);
#pragma unroll
                    for (int j = 0; j < 8; ++j) { const float x = v[j]; v[j] = x * sigm(1.5957691216f * (x + 0.044715f * x * x * x)); }
                    u32x4 w; w.x = cvt_pk_bf16(v[0], v[1]); w.y = cvt_pk_bf16(v[2], v[3]); w.z = cvt_pk_bf16(v[4], v[5]); w.w = cvt_pk_bf16(v[6], v[7]);
                    *(u32x4*)(Y + ((size_t)b * 4096 + c * 16 + t) * 512 + g * 16 + p0) = w;
                } }
    }
    __device__ __forceinline__ void midscale(f32x4 (&)[2][2][4][2], const Unit&, int, int) const {}
};

template <class Epi, class Sched, bool ALIGN_EPI = false, bool SP2 = true>
__device__ __forceinline__ void gemm_phase(PG8_LAS unsigned char* lds, const Gemm g, const Sched& S, const Epi& E) {
    const int tid = threadIdx.x, wid = __builtin_amdgcn_readfirstlane(tid >> 6), lane = tid & 63, wr = wid >> 2, wc = wid & 3, fr = lane & 15, fq = lane >> 4;
    int nt = g.K / BK; asm volatile("" : "+s"(nt));
    unsigned voffA[2], voffB[2];
#pragma unroll
    for (int i = 0; i < 2; ++i) { int R, C; stage_rc(tid * 16 + i * 8192, R, C); const int Rb = Epi::PERM ? ((R & ~31) + perm32(R & 31)) : R;
        voffA[i] = (unsigned)(R * g.lda + C) * 2u; voffB[i] = (unsigned)(Rb * g.ldb + C) * 2u; }
    const size_t kstep = (size_t)(BK * 2);
    const size_t hstepA = (size_t)HALF * g.lda * 2, hstepB = (size_t)HALF * g.ldb * 2;
    const size_t tstepA = 2 * hstepA, tstepB = 2 * hstepB;
    const unsigned ldsw = (unsigned)wid * 1024u;
    const int aoff = lds_byte(wr * 64 + fr, fq * 8), boff = lds_byte(wc * 32 + fr, fq * 8);
#define PG8_SA(b, h) (((b) * 2 + (h)) * HTB)
#define PG8_SB(b, h) ((4 + (b) * 2 + (h)) * HTB)
#define PG8_STAGE(bufoff, gbase, voff) do { _Pragma("unroll") for (int _i = 0; _i < 2; ++_i) \
        __builtin_amdgcn_global_load_lds((const unsigned*)((const char*)(gbase) + (voff)[_i]), (PG8_LAS unsigned*)(lds + (bufoff) + ldsw + _i * 8192), 16, 0, 0); } while (0)
#define PG8_LDA(dst, b, h) do { _Pragma("unroll") for (int m = 0; m < 4; ++m) _Pragma("unroll") for (int k = 0; k < 2; ++k) dst[m][k] = *(const PG8_LAS bf16x8*)(lds + PG8_SA(b, h) + aoff + m * 2048 + k * 1024); } while (0)
#define PG8_LDB(dst, b, h) do { _Pragma("unroll") for (int n = 0; n < 2; ++n) _Pragma("unroll") for (int k = 0; k < 2; ++k) dst[n][k] = *(const PG8_LAS bf16x8*)(lds + PG8_SB(b, h) + boff + n * 2048 + k * 1024); } while (0)
#define PG8_MMA(ai, bj, At, Bt) do { __builtin_amdgcn_s_setprio(1); _Pragma("unroll") for (int m = 0; m < 4; ++m) _Pragma("unroll") for (int n = 0; n < 2; ++n) _Pragma("unroll") for (int k = 0; k < 2; ++k) \
        acc[ai][bj][m][n] = __builtin_amdgcn_mfma_f32_16x16x32_bf16(Bt[n][k], At[m][k], acc[ai][bj][m][n], 0, 0, 0); __builtin_amdgcn_s_setprio(0); } while (0)
#define PG8_WAIT_V(n) asm volatile("s_waitcnt vmcnt(" #n ")" ::: "memory")
#define PG8_WAIT_L(n) asm volatile("s_waitcnt lgkmcnt(" #n ")" ::: "memory")
#define PG8_BAR __builtin_amdgcn_s_barrier()
#define PG8_SCHED __builtin_amdgcn_sched_barrier(0)
    Unit cur, nxt; int ui = 0;
    if (!S.next(0, cur)) return;
    f32x4 acc[2][2][4][2];
#pragma unroll
    for (int a = 0; a < 2; ++a)
#pragma unroll
        for (int b = 0; b < 2; ++b)
#pragma unroll
            for (int m = 0; m < 4; ++m)
#pragma unroll
                for (int n = 0; n < 2; ++n) acc[a][b][m][n] = (f32x4){0.f, 0.f, 0.f, 0.f};
    bf16x8 At[4][2], B0[2][2], B1[2][2];
    const char* cA = (const char*)g.A + (size_t)cur.pm * tstepA; const char* cB = (const char*)g.Bt + (size_t)cur.pn * tstepB;
    if constexpr (SP2) {
        PG8_STAGE(PG8_SB(0, 0), cB, voffB); PG8_STAGE(PG8_SB(0, 1), cB + hstepB, voffB); PG8_STAGE(PG8_SA(0, 0), cA, voffA); PG8_STAGE(PG8_SA(0, 1), cA + hstepA, voffA);
        if (wr == 1) PG8_BAR;
        PG8_WAIT_V(2); PG8_BAR;
        PG8_STAGE(PG8_SB(1, 0), cB + kstep, voffB); PG8_STAGE(PG8_SA(1, 0), cA + kstep, voffA); PG8_STAGE(PG8_SB(1, 1), cB + hstepB + kstep, voffB);
        PG8_WAIT_V(6); PG8_BAR;
    } else {
        PG8_STAGE(PG8_SB(0, 0), cB, voffB); PG8_STAGE(PG8_SA(0, 0), cA, voffA); PG8_STAGE(PG8_SB(0, 1), cB + hstepB, voffB); PG8_STAGE(PG8_SA(0, 1), cA + hstepA, voffA);
        if (wr == 1) PG8_BAR;
        PG8_WAIT_V(4); PG8_BAR;
        PG8_STAGE(PG8_SB(1, 0), cB + kstep, voffB); PG8_STAGE(PG8_SA(1, 0), cA + kstep, voffA); PG8_STAGE(PG8_SB(1, 1), cB + hstepB + kstep, voffB);
        PG8_WAIT_V(6); PG8_BAR;
    }
    for (;;) {
        const bool has_next = S.next(ui + 1, nxt);
        const char* nA = has_next ? (const char*)g.A + (size_t)nxt.pm * tstepA : cA; const char* nB = has_next ? (const char*)g.Bt + (size_t)nxt.pn * tstepB : cB;
        for (int t = 0; t < nt; t += 2) {
            const bool last = (t == nt - 2);
            const char* a1 = cA + (size_t)(t + 1) * kstep;
            const char* a2 = last ? nA : cA + (size_t)(t + 2) * kstep; const char* b2 = last ? nB : cB + (size_t)(t + 2) * kstep;
            const char* a3 = a2 + kstep; const char* b3 = b2 + kstep;
            if constexpr (Epi::MIDSCALE) { if (t == (nt >> 1)) E.midscale(acc, cur, wr, fr); }
            if constexpr (SP2) {
            PG8_LDB(B0, 0, 0); PG8_LDB(B1, 0, 1); PG8_SCHED; PG8_LDA(At, 0, 0); PG8_STAGE(PG8_SA(1, 1), a1 + hstepA, voffA);
            PG8_WAIT_V(8); PG8_WAIT_L(0); PG8_BAR; PG8_MMA(0, 0, At, B0); PG8_MMA(0, 1, At, B1); PG8_BAR; PG8_SCHED;
            PG8_LDA(At, 0, 1); PG8_STAGE(PG8_SB(0, 0), b2, voffB); PG8_STAGE(PG8_SB(0, 1), b2 + hstepB, voffB); PG8_STAGE(PG8_SA(0, 0), a2, voffA);
            PG8_WAIT_V(8); PG8_WAIT_L(0); PG8_BAR; PG8_MMA(1, 0, At, B0); PG8_MMA(1, 1, At, B1); PG8_BAR; PG8_SCHED;
            PG8_LDB(B0, 1, 0); PG8_LDB(B1, 1, 1); PG8_SCHED; PG8_LDA(At, 1, 0); PG8_STAGE(PG8_SA(0, 1), a2 + hstepA, voffA);
            PG8_WAIT_V(8); PG8_WAIT_L(0); PG8_BAR; PG8_MMA(0, 0, At, B0); PG8_MMA(0, 1, At, B1); PG8_BAR; PG8_SCHED;
            PG8_LDA(At, 1, 1); PG8_STAGE(PG8_SB(1, 0), b3, voffB); PG8_STAGE(PG8_SB(1, 1), b3 + hstepB, voffB); PG8_STAGE(PG8_SA(1, 0), a3, voffA);
            PG8_WAIT_V(8); PG8_WAIT_L(0); PG8_BAR; PG8_MMA(1, 0, At, B0); PG8_MMA(1, 1, At, B1); PG8_BAR; PG8_SCHED;
            } else {
            PG8_LDB(B0, 0, 0); PG8_SCHED; PG8_LDA(At, 0, 0); PG8_STAGE(PG8_SA(1, 1), a1 + hstepA, voffA);
            PG8_WAIT_L(8); PG8_BAR; PG8_WAIT_L(0); PG8_MMA(0, 0, At, B0); PG8_BAR; PG8_SCHED;
            PG8_LDB(B1, 0, 1); PG8_STAGE(PG8_SB(0, 0), b2, voffB);
            PG8_BAR; PG8_WAIT_L(0); PG8_MMA(0, 1, At, B1); PG8_BAR;
            PG8_LDA(At, 0, 1); PG8_STAGE(PG8_SA(0, 0), a2, voffA);
            PG8_BAR; PG8_WAIT_L(0); PG8_MMA(1, 0, At, B0); PG8_BAR; PG8_SCHED;
            PG8_STAGE(PG8_SB(0, 1), b2 + hstepB, voffB);
            PG8_WAIT_V(6); PG8_BAR; PG8_MMA(1, 1, At, B1); PG8_BAR;
            PG8_LDB(B0, 1, 0); PG8_SCHED; PG8_LDA(At, 1, 0); PG8_STAGE(PG8_SA(0, 1), a2 + hstepA, voffA);
            PG8_WAIT_L(8); PG8_BAR; PG8_WAIT_L(0); PG8_MMA(0, 0, At, B0); PG8_BAR; PG8_SCHED;
            PG8_LDB(B1, 1, 1); PG8_STAGE(PG8_SB(1, 0), b3, voffB);
            PG8_BAR; PG8_WAIT_L(0); PG8_MMA(0, 1, At, B1); PG8_BAR;
            PG8_LDA(At, 1, 1); PG8_STAGE(PG8_SA(1, 0), a3, voffA);
            PG8_BAR; PG8_WAIT_L(0); PG8_MMA(1, 0, At, B0); PG8_BAR; PG8_SCHED;
            PG8_STAGE(PG8_SB(1, 1), b3 + hstepB, voffB);
            PG8_WAIT_V(6); PG8_BAR; PG8_MMA(1, 1, At, B1); PG8_BAR;
            }
        }
        if constexpr (ALIGN_EPI) { if (wr == 0) PG8_BAR; }
        if constexpr (!Epi::AFTER_DRAIN) { E(acc, cur, wr, wc, fr, fq); }
        if (!has_next) break;
#pragma unroll
        for (int a = 0; a < 2; ++a)
#pragma unroll
            for (int b = 0; b < 2; ++b)
#pragma unroll
                for (int m = 0; m < 4; ++m)
#pragma unroll
                    for (int n = 0; n < 2; ++n) acc[a][b][m][n] = (f32x4){0.f, 0.f, 0.f, 0.f};
        cur = nxt; cA = nA; cB = nB; ++ui;
        if constexpr (ALIGN_EPI) { if (wr == 1) PG8_BAR; }
    }
    PG8_WAIT_V(0);
    if constexpr (!ALIGN_EPI) { if (wr == 0) PG8_BAR; }
    PG8_BAR;
    if constexpr (Epi::AFTER_DRAIN) { E.fused(acc, cur, wr, wc, fr, fq, lds, wid, lane); }
#undef PG8_SA
#undef PG8_SB
#undef PG8_STAGE
#undef PG8_LDA
#undef PG8_LDB
#undef PG8_MMA
#undef PG8_WAIT_V
#undef PG8_WAIT_L
#undef PG8_BAR
#undef PG8_SCHED
}
}

constexpr int NWAVES = 8;
constexpr int N_LAUNCHES = MK_N_LAUNCHES;
constexpr int NPHASE = 11;
constexpr int M = 32768, D = 1024, FF = 2816, NFF2 = 2 * FF, SW = 512, PLE = 256, SEQ = 4096;
constexpr int NG = 32, NS = 64, GP = 16;
constexpr size_t MiB = 1u << 20;
constexpr size_t WS_CTL = 0, CTL_ZERO_BYTES = 1 * MiB;
constexpr size_t WS_W13A = 2 * MiB, WS_W2A = 13 * MiB, WS_W13B = 19 * MiB, WS_W2B = 30 * MiB;
constexpr size_t WS_WIN = 36 * MiB, WS_WGLU = 38 * MiB, WS_WO = 39 * MiB, WS_WG = 41 * MiB, WS_WPP = 43 * MiB;
constexpr size_t WS_S5BT = 44 * MiB, WS_S5WE = 50 * MiB, WS_A16 = 54 * MiB;
constexpr size_t WS_SS0 = 56 * MiB, WS_SS1 = 58 * MiB, WS_SSS = 60 * MiB, WS_SS2 = 62 * MiB, WS_SS3 = 64 * MiB, WS_SSE = 66 * MiB, WS_SS4 = 68 * MiB;
constexpr size_t WS_HB = 72 * MiB, WS_PB = 136 * MiB, WS_E = 152 * MiB, WS_A5 = 216 * MiB, WS_ACT = 280 * MiB;
constexpr size_t WS_AEXT = WS_ACT, WS_Q = 328 * MiB, WS_YACT = 360 * MiB, WS_END = 456 * MiB;
static_assert(WS_W13A + (size_t)NFF2 * D * 2 <= WS_W2A && WS_W2A + (size_t)D * FF * 2 <= WS_W13B && WS_W13B + (size_t)NFF2 * D * 2 <= WS_W2B && WS_W2B + (size_t)D * FF * 2 <= WS_WIN, "ws map 1");
static_assert(WS_S5BT + (size_t)NG * 256 * 384 * 2 <= WS_S5WE && WS_S5WE + (size_t)NG * 256 * 256 * 2 <= WS_A16, "ws map 2");
static_assert(WS_ACT + (size_t)M * FF * 2 <= WS_END && WS_AEXT + (size_t)256 * 256 * 384 * 2 <= WS_Q && WS_Q + (size_t)M * 512 * 2 <= WS_YACT && WS_YACT + (size_t)M * 512 * 2 <= WS_END, "ws map 3");
constexpr int CW_BAR = 4096;
constexpr int RING_OFF = 0, RING_BYTES = 131072, LDSCTL_OFF = RING_BYTES, MISC_OFF = LDSCTL_OFF + 320, LDS_BYTES = 147456;

#define LAS __attribute__((address_space(3)))
typedef unsigned short bf16;
typedef unsigned v4u __attribute__((ext_vector_type(4)));
typedef unsigned v2u __attribute__((ext_vector_type(2)));
typedef float f32x4 __attribute__((ext_vector_type(4)));
#define LDS_WAIT() asm volatile("s_waitcnt lgkmcnt(0)" ::: "memory")
#define VM_WAIT() asm volatile("s_waitcnt vmcnt(0)" ::: "memory")
using pg8::cvt_pk_bf16;
__device__ __forceinline__ unsigned short f2bf(float f) { return (unsigned short)(cvt_pk_bf16(f, 0.f) & 0xffffu); }

#define XB_TMO      128
#define XB_XCNT(j)  (256  + 64 * (j))
#define XB_XSUB(j)  (1280 + 64 * (j))
#define XB_XGEN(j)  (2304 + 64 * (j))
#define XB_TOP      3328
#define XB_TOPGEN   3392
#define XCD_BAR_WORDS 3456
#define XB_SPIN_CAP (1u << 20)
__device__ __forceinline__ unsigned xb_ld(unsigned* p)              { return __hip_atomic_load(p, __ATOMIC_RELAXED, __HIP_MEMORY_SCOPE_AGENT); }
__device__ __forceinline__ unsigned xb_add(unsigned* p, unsigned v) { return __hip_atomic_fetch_add(p, v, __ATOMIC_RELAXED, __HIP_MEMORY_SCOPE_AGENT); }
__device__ __forceinline__ unsigned xb_xcc_id() { return (unsigned)__builtin_amdgcn_s_getreg((3 << 11) | 20) & 0xFu; }
#define XB_SPIN(cond, bar) do { unsigned _sp = 0; while (cond) { __builtin_amdgcn_s_sleep(1); \
    if ((++_sp & 255u) == 0u) { if (xb_ld(&(bar)[XB_TMO])) break; if (_sp > XB_SPIN_CAP) { atomicAdd(&(bar)[XB_TMO], 1u); break; } } } } while (0)
struct XcdBarrier { unsigned* bar; unsigned x; volatile LAS unsigned* st; };
__device__ __forceinline__ XcdBarrier xcd_barrier_post(unsigned* bar, volatile LAS unsigned* st) {
    XcdBarrier b; b.bar = bar; b.x = xb_xcc_id(); b.st = st;
    if (threadIdx.x == 0) (void)xb_add(&bar[XB_XCNT(b.x)], 1u);
    return b;
}
__device__ __forceinline__ void xcd_barrier_complete(unsigned* bar, unsigned x, unsigned& nloc, unsigned& nx) {
    const unsigned G = gridDim.x * gridDim.y * gridDim.z;
    unsigned sum, cnt, mine, sp = 0u;
    for (;;) {
        sum = 0u; cnt = 0u; mine = 0u;
#pragma unroll
        for (unsigned j = 0; j < 16; ++j) { const unsigned c = xb_ld(&bar[XB_XCNT(j)]); sum += c; cnt += (c > 0u) ? 1u : 0u; mine = (j == x) ? c : mine; }
        if (sum == G) break;
        __builtin_amdgcn_s_sleep(1);
        if ((++sp & 255u) == 0u) { if (xb_ld(&bar[XB_TMO])) break; if (sp > XB_SPIN_CAP) { atomicAdd(&bar[XB_TMO], 1u); break; } }
    }
    nloc = mine > 0u ? mine : 1u; nx = cnt > 0u ? cnt : 1u;
}
__device__ __forceinline__ void xcd_barrier(const XcdBarrier& b) {
    asm volatile("s_waitcnt vmcnt(0)" ::: "memory");
    __syncthreads();
    if (threadIdx.x == 0) {
        unsigned* bar = b.bar;
        __builtin_amdgcn_s_waitcnt(0);
        unsigned nloc = b.st[0], nx = b.st[1];
        if (nloc == 0u) { xcd_barrier_complete(bar, b.x, nloc, nx); b.st[0] = nloc; b.st[1] = nx; }
        const unsigned old = xb_add(&bar[XB_XSUB(b.x)], 1u);
        const unsigned gen = old / nloc;
        if (old + 1u == (gen + 1u) * nloc) {
            __builtin_amdgcn_fence(__ATOMIC_RELEASE, "agent");
            asm volatile("s_waitcnt vmcnt(0)" ::: "memory");
            const unsigned og = xb_add(&bar[XB_TOP], 1u);
            const unsigned tg = og / nx;
            if (og + 1u == (tg + 1u) * nx) xb_add(&bar[XB_TOPGEN], 1u);
            else XB_SPIN(xb_ld(&bar[XB_TOPGEN]) == tg, bar);
            __builtin_amdgcn_fence(__ATOMIC_ACQUIRE, "agent");
            xb_add(&bar[XB_XGEN(b.x)], 1u);
            asm volatile("s_waitcnt vmcnt(0)" ::: "memory");
        } else {
            XB_SPIN(xb_ld(&bar[XB_XGEN(b.x)]) == gen, bar);
            __builtin_amdgcn_fence(__ATOMIC_ACQUIRE, "agent");
            asm volatile("s_waitcnt vmcnt(0)" ::: "memory");
        }
    }
    __syncthreads();
}

__device__ __forceinline__ float wave_sum(float v) {
#pragma unroll
    for (int o = 1; o < 64; o <<= 1) v += __shfl_xor(v, o);
    return v;
}
__device__ __forceinline__ void transpose_item(const float* W, int K, int N, bf16* WT, int k0, int n0, int drow0, const float* gain, float scale, LAS float* scr, int lane) {
#pragma unroll 8
    for (int i = 0; i < 32; ++i) { const int kk = 2 * i + (lane >> 5); const float gk = gain ? gain[k0 + kk] * scale : scale; scr[kk * 33 + (lane & 31)] = W[(size_t)(k0 + kk) * N + n0 + (lane & 31)] * gk; }
    LDS_WAIT(); asm volatile("" ::: "memory");
    const int c = lane & 7;
#pragma unroll
    for (int j = 0; j < 4; ++j) { const int n = (lane >> 3) + 8 * j; const LAS float* s = scr + (8 * c) * 33 + n;
        v4u o; o.x = cvt_pk_bf16(s[0 * 33], s[1 * 33]); o.y = cvt_pk_bf16(s[2 * 33], s[3 * 33]); o.z = cvt_pk_bf16(s[4 * 33], s[5 * 33]); o.w = cvt_pk_bf16(s[6 * 33], s[7 * 33]);
        *(v4u*)(WT + (size_t)(drow0 + n) * K + k0 + 8 * c) = o; }
    LDS_WAIT(); asm volatile("" ::: "memory");
}
__device__ __forceinline__ void cpow(float lr, float li, float dt, float e, float& pr, float& pi) {
    const float mag = expf(lr * dt * e); float s, c; sincosf(li * dt * e, &s, &c); pr = mag * c; pi = mag * s;
}

struct Args { const float* in[32]; float* out; unsigned char* ws; int ph_lo, ph_hi, li, pad; };

__global__ void __launch_bounds__(NWAVES * 64, 2) hymba_fwd(Args args) {
    extern __shared__ __attribute__((aligned(16))) unsigned char lds_raw[];
    LAS unsigned char* lds = (LAS unsigned char*)lds_raw;
    volatile LAS unsigned* MISC = (volatile LAS unsigned*)(lds + MISC_OFF);
    const int tid = threadIdx.x, lane = tid & 63, wave = __builtin_amdgcn_readfirstlane(tid >> 6);
    const int G = gridDim.x, bx = blockIdx.x;
    const int vcu = (G % 8 == 0) ? (bx % 8) * (G / 8) + bx / 8 : bx;
    unsigned char* ws = args.ws;
    unsigned* ctl = (unsigned*)(ws + WS_CTL);
    const float* x = args.in[0]; const float* pin = args.in[1];
    const float* ffn1_norm = args.in[2]; const float* ffn1_w1 = args.in[3]; const float* ffn1_w3 = args.in[4]; const float* ffn1_w2 = args.in[5];
    const float* mix_norm = args.in[6]; const float* w_in = args.in[7];
    const float* a_re = args.in[8]; const float* a_im = args.in[9]; const float* log_dt = args.in[10];
    const float* b_re = args.in[11]; const float* b_im = args.in[12]; const float* c_re = args.in[13]; const float* c_im = args.in[14];
    const float* d_skip = args.in[15]; const float* w_glu = args.in[16]; const float* b_glu = args.in[17];
    const float* w_pool = args.in[18]; const float* pool_scale = args.in[19];
    const float* ssm_out_norm = args.in[20]; const float* pool_out_norm = args.in[21]; const float* w_out = args.in[22];
    const float* ffn2_norm = args.in[23]; const float* ffn2_w1 = args.in[24]; const float* ffn2_w3 = args.in[25]; const float* ffn2_w2 = args.in[26];
    const float* ple_gate_norm = args.in[27]; const float* w_ple_gate = args.in[28]; const float* w_ple_proj = args.in[29];
    const float* ple_norm = args.in[30]; const float* final_norm = args.in[31];
    float* out = args.out;
    bf16* W13A = (bf16*)(ws + WS_W13A); bf16* W2A = (bf16*)(ws + WS_W2A); bf16* W13B = (bf16*)(ws + WS_W13B); bf16* W2B = (bf16*)(ws + WS_W2B);
    bf16* WIN = (bf16*)(ws + WS_WIN); bf16* WGLU = (bf16*)(ws + WS_WGLU); bf16* WO = (bf16*)(ws + WS_WO); bf16* WG = (bf16*)(ws + WS_WG); bf16* WPP = (bf16*)(ws + WS_WPP);
    bf16* S5BT = (bf16*)(ws + WS_S5BT); bf16* S5WE = (bf16*)(ws + WS_S5WE); float* A16 = (float*)(ws + WS_A16);
    float* SS0 = (float*)(ws + WS_SS0); float* SS1 = (float*)(ws + WS_SS1); float* SSS = (float*)(ws + WS_SSS); float* SS2 = (float*)(ws + WS_SS2);
    float* SS3 = (float*)(ws + WS_SS3); float* SSE = (float*)(ws + WS_SSE); float* SS4 = (float*)(ws + WS_SS4);
    bf16* HB = (bf16*)(ws + WS_HB); bf16* PB = (bf16*)(ws + WS_PB); bf16* EB = (bf16*)(ws + WS_E); bf16* A5 = (bf16*)(ws + WS_A5);
    bf16* ACT = (bf16*)(ws + WS_ACT); bf16* AEXT = (bf16*)(ws + WS_AEXT); bf16* QB = (bf16*)(ws + WS_Q); bf16* YACT = (bf16*)(ws + WS_YACT);

    for (int u = tid; u < (LDS_BYTES - LDSCTL_OFF) / 4; u += NWAVES * 64) ((LAS unsigned*)(lds + LDSCTL_OFF))[u] = 0u;
    __syncthreads();
    XcdBarrier bar; bar.bar = ctl + CW_BAR + args.li * XCD_BAR_WORDS; bar.x = 0; bar.st = nullptr;
    if (args.ph_hi - args.ph_lo > 1) bar = xcd_barrier_post(ctl + CW_BAR + args.li * XCD_BAR_WORDS, MISC + 8);
    const int lo = args.ph_lo, hi = args.ph_hi;
#ifndef PH_MASK
#define PH_MASK 0x7ff
#endif
#define IN(k) ((((PH_MASK) >> (k)) & 1) && lo <= (k) && (k) < hi)
#define SEAM(k) do { if (IN(k) && IN((k) + 1)) xcd_barrier(bar); } while (0)
    const int gw = vcu * NWAVES + wave, NGW = G * NWAVES;

    if (IN(0)) {
        LAS float* scr = (LAS float*)(lds + RING_OFF + wave * 16384);
        for (int it = gw; it < NG * 16; it += NGW) {
            const int g = it >> 4, j = it & 15, n = lane;
            const float dt = expf(log_dt[g]); const float lr = a_re[g * NS + n], li = a_im[g * NS + n];
            float abr, abi; cpow(lr, li, dt, 1.0f, abr, abi);
            const float den = lr * lr + li * li, nr = abr - 1.0f;
            const float f_r = (nr * lr + abi * li) / den, f_i = (abi * lr - nr * li) / den;
            float Bbr[16], Bbi[16];
            { const f32x4* brp = (const f32x4*)(b_re + (size_t)(g * NS + n) * 16); const f32x4* bip = (const f32x4*)(b_im + (size_t)(g * NS + n) * 16);
#pragma unroll
              for (int q4 = 0; q4 < 4; ++q4) { const f32x4 br = brp[q4], bi = bip[q4];
#pragma unroll
                  for (int e = 0; e < 4; ++e) { Bbr[4 * q4 + e] = f_r * br[e] - f_i * bi[e]; Bbi[4 * q4 + e] = f_r * bi[e] + f_i * br[e]; } } }
            float pjr, pji, p1r, p1i, p2r, p2i;
            cpow(lr, li, dt, (float)j, pjr, pji); cpow(lr, li, dt, (float)(j + 1), p1r, p1i); cpow(lr, li, dt, (float)(15 - j), p2r, p2i);
            if (j == 0) { float ar, ai; cpow(lr, li, dt, 16.0f, ar, ai); A16[(g * NS + n) * 2] = ar; A16[(g * NS + n) * 2 + 1] = ai; }
            { bf16* we = S5WE + (size_t)(g * 256) * 256 + j * 16;
              unsigned wr_[8], wi_[8];
#pragma unroll
              for (int q = 0; q < 16; q += 2) { const float r0 = p2r * Bbr[q] - p2i * Bbi[q], i0 = p2r * Bbi[q] + p2i * Bbr[q], r1 = p2r * Bbr[q + 1] - p2i * Bbi[q + 1], i1 = p2r * Bbi[q + 1] + p2i * Bbr[q + 1];
                  wr_[q >> 1] = cvt_pk_bf16(r0, r1); wi_[q >> 1] = cvt_pk_bf16(i0, i1); }
              *(v4u*)(we + (size_t)n * 256) = (v4u){wr_[0], wr_[1], wr_[2], wr_[3]}; *(v4u*)(we + (size_t)n * 256 + 8) = (v4u){wr_[4], wr_[5], wr_[6], wr_[7]};
              *(v4u*)(we + (size_t)(64 + n) * 256) = (v4u){wi_[0], wi_[1], wi_[2], wi_[3]}; *(v4u*)(we + (size_t)(64 + n) * 256 + 8) = (v4u){wi_[4], wi_[5], wi_[6], wi_[7]};
              bf16* z = S5WE + (size_t)(g * 256 + 128 + 8 * j) * 256 + lane * 32;
#pragma unroll
              for (int e = 0; e < 4; ++e) *(v4u*)(z + 8 * e) = (v4u){0u, 0u, 0u, 0u}; }
#pragma unroll
            for (int q = 0; q < 16; ++q) { const float wr_ = pjr * Bbr[q] - pji * Bbi[q], wi_ = pjr * Bbi[q] + pji * Bbr[q]; Bbr[q] = wr_; Bbi[q] = wi_; }
            bf16* btg = S5BT + (size_t)(g * 256) * 384;
#pragma unroll 1
            for (int p = 0; p < 16; ++p) {
                const float cr = c_re[(size_t)(g * 16 + p) * NS + n], ci = c_im[(size_t)(g * 16 + p) * NS + n];
                { const float re = cr * p1r - ci * p1i, im = cr * p1i + ci * p1r; bf16* row = btg + (size_t)(j * 16 + p) * 384; row[n] = f2bf(re); row[64 + n] = f2bf(-im); }
                float mine = 0.f;
#pragma unroll
                for (int q = 0; q < 16; ++q) { const float v = wave_sum(cr * Bbr[q] - ci * Bbi[q]); mine = (lane == q) ? v : mine; }
                if (lane < 16) { const bf16 val = f2bf(mine);
                    for (int t = j; t < 16; ++t) btg[(size_t)(t * 16 + p) * 384 + 128 + (t - j) * 16 + lane] = val;
                    if (j > 0) for (int t = 0; t < 16 - j; ++t) btg[(size_t)(t * 16 + p) * 384 + 128 + (t + j) * 16 + lane] = 0; }
            }
        }
        for (int it = gw; it < (D / 8) * (SW / 64); it += NGW) {
            const int kb = it >> 3, db = it & 7, d = db * 64 + lane, gi = d >> 7, dd = d & 127, k0 = kb * 8;
            float a[8];
#pragma unroll
            for (int kk = 0; kk < 8; ++kk) a[kk] = 0.f;
            const float* wp = w_pool + (size_t)gi * 128 * 128 + dd;
            const float* wi = w_in + (size_t)k0 * D + 512 + gi * 128;
            for (int c = 0; c < 128; ++c) { const float wv = wp[(size_t)c * 128];
#pragma unroll
                for (int kk = 0; kk < 8; ++kk) a[kk] += wi[(size_t)kk * D + c] * wv; }
            const float ps = pool_scale[d];
            v4u o; o.x = cvt_pk_bf16(a[0] * ps * mix_norm[k0 + 0], a[1] * ps * mix_norm[k0 + 1]); o.y = cvt_pk_bf16(a[2] * ps * mix_norm[k0 + 2], a[3] * ps * mix_norm[k0 + 3]);
            o.z = cvt_pk_bf16(a[4] * ps * mix_norm[k0 + 4], a[5] * ps * mix_norm[k0 + 5]); o.w = cvt_pk_bf16(a[6] * ps * mix_norm[k0 + 6], a[7] * ps * mix_norm[k0 + 7]);
            *(v4u*)(WIN + (size_t)(512 + d) * D + k0) = o;
        }
        {
            constexpr int I_FF = (D / 64) * (FF / 32);
            constexpr int I_W2 = (FF / 64) * (D / 32);
            constexpr int I_SQ = (D / 64) * (D / 32);
            constexpr int I_IN = (D / 64) * (SW / 32);
            constexpr int I_GL = (SW / 64) * (SW / 32);
            constexpr int I_PP = (PLE / 64) * (D / 32);
            constexpr int NIT = 4 * I_FF + 2 * I_W2 + 2 * I_SQ + I_IN + I_GL + I_PP;
            for (int it = gw; it < NIT; it += NGW) {
                int r = it;
                if (r < 4 * I_FF) { const int which = r / I_FF; r -= which * I_FF; const int nb = FF / 32, kb = r / nb, n0 = (r % nb) * 32;
                    const float* W = which == 0 ? ffn1_w1 : which == 1 ? ffn1_w3 : which == 2 ? ffn2_w1 : ffn2_w3; bf16* WT = which < 2 ? W13A : W13B;
                    const int drow0 = (n0 >> 7) * 256 + (n0 & 127) + (which & 1) * 128;
                    transpose_item(W, D, FF, WT, kb * 64, n0, drow0, which < 2 ? ffn1_norm : ffn2_norm, 1.0f, scr, lane); continue; }
                r -= 4 * I_FF;
                if (r < 2 * I_W2) { const int which = r / I_W2; r -= which * I_W2; const int nb = D / 32, kb = r / nb, n0 = (r % nb) * 32;
                    transpose_item(which ? ffn2_w2 : ffn1_w2, FF, D, which ? W2B : W2A, kb * 64, n0, n0, nullptr, 0.5f, scr, lane); continue; }
                r -= 2 * I_W2;
                if (r < 2 * I_SQ) { const int which = r / I_SQ; r -= which * I_SQ; const int nb = D / 32, kb = r / nb, n0 = (r % nb) * 32;
                    if (which == 0) { const float* gn = (kb * 64 < SW) ? ssm_out_norm + kb * 64 : pool_out_norm + (kb * 64 - SW);
                        transpose_item(w_out, D, D, WO, kb * 64, n0, n0, gn - kb * 64, 1.0f, scr, lane); }
                    else transpose_item(w_ple_gate, D, D, WG, kb * 64, n0, n0, ple_gate_norm, 1.0f, scr, lane);
                    continue; }
                r -= 2 * I_SQ;
                if (r < I_IN) { const int nb = SW / 32, kb = r / nb, n0 = (r % nb) * 32; transpose_item(w_in, D, D, WIN, kb * 64, n0, n0, mix_norm, 1.0f, scr, lane); continue; }
                r -= I_IN;
                if (r < I_GL) { const int nb = SW / 32, kb = r / nb, n0 = (r % nb) * 32; transpose_item(w_glu, SW, SW, WGLU, kb * 64, n0, n0, nullptr, 1.0f, scr, lane); continue; }
                r -= I_GL;
                { const int nb = D / 32, kb = r / nb, n0 = (r % nb) * 32; transpose_item(w_ple_proj, PLE, D, WPP, kb * 64, n0, n0, nullptr, 1.0f, scr, lane); }
            }
        }
        for (int r = gw; r < M; r += NGW) {
            const f32x4* xr = (const f32x4*)(x + (size_t)r * D) + lane; f32x4 v[4]; float s = 0.f;
#pragma unroll
            for (int j = 0; j < 4; ++j) { v[j] = xr[64 * j]; s += (v[j][0] * v[j][0] + v[j][1] * v[j][1]) + (v[j][2] * v[j][2] + v[j][3] * v[j][3]); }
            s = wave_sum(s); if (lane == 0) SS0[r] = s;
            v2u* o8 = (v2u*)(HB + (size_t)r * D) + lane;
#pragma unroll
            for (int j = 0; j < 4; ++j) { v2u w; w.x = cvt_pk_bf16(v[j][0], v[j][1]); w.y = cvt_pk_bf16(v[j][2], v[j][3]); o8[64 * j] = w; }
            const f32x4 pv = *((const f32x4*)(pin + (size_t)r * PLE) + lane);
            v2u w; w.x = cvt_pk_bf16(pv[0], pv[1]); w.y = cvt_pk_bf16(pv[2], pv[3]); *((v2u*)(PB + (size_t)r * PLE) + lane) = w;
        }
    }
    SEAM(0);

    if (IN(1)) {
        { pg8::Gemm g{PB, WPP, PLE, PLE, PLE}; pg8::StaticOrder S; S.init(M, D, G, bx); pg8::EpiEmb E{EB, SSE};
          pg8::gemm_phase<pg8::EpiEmb, pg8::StaticOrder, true>(lds + RING_OFF, g, S, E); }
        { pg8::Gemm g{HB, W13A, D, D, D}; pg8::StaticOrder S; S.init(M, NFF2, G, bx); pg8::EpiSwiGLU<1> E{ACT, FF, SS0, 1.0f / 1024.0f};
          pg8::gemm_phase<pg8::EpiSwiGLU<1>, pg8::StaticOrder, true>(lds + RING_OFF, g, S, E); }
    }
    SEAM(1);
    if (IN(2)) {
        pg8::Gemm g{ACT, W2A, FF, FF, FF}; pg8::StaticOrder S; S.init(M, D, G, bx); pg8::EpiResid<false> E{x, out, HB, SS1, nullptr, 0.f};
        pg8::gemm_phase<pg8::EpiResid<false>, pg8::StaticOrder, true>(lds + RING_OFF, g, S, E);
    }
    SEAM(2);
    if (IN(3)) {
        pg8::Gemm g{HB, WIN, D, D, D}; pg8::StaticOrder S; S.init(M, D, G, bx); pg8::EpiWin E{AEXT, QB, SS1};
        pg8::gemm_phase<pg8::EpiWin, pg8::StaticOrder, true>(lds + RING_OFF, g, S, E);
    }
    SEAM(3);
    if (IN(4)) {
        for (int unit = bx; unit < 256; unit += G) {
            const int g_ = unit >> 3;
            { pg8::Gemm g{AEXT + 128, S5WE, 384, 256, 256}; pg8::SingleUnit S{unit, g_}; pg8::EpiS5End E{};
              pg8::gemm_phase<pg8::EpiS5End, pg8::SingleUnit, false>(lds + RING_OFF, g, S, E); }
            LDS_WAIT(); __syncthreads();
            if (wave == 0) {
                const LAS float* El = (const LAS float*)(lds + RING_OFF);
                const float ar = A16[(g_ * NS + lane) * 2], ai = A16[(g_ * NS + lane) * 2 + 1];
                float cr = 0.f, ci = 0.f;
                bf16* dst = AEXT + (size_t)unit * 256 * 384 + lane;
                for (int c = 0; c < 256; ++c) {
                    dst[(size_t)c * 384] = f2bf(cr); dst[(size_t)c * 384 + 64] = f2bf(ci);
                    const float er = El[c * 128 + lane], ei = El[c * 128 + 64 + lane];
                    const float nr = ar * cr - ai * ci + er, ni = ar * ci + ai * cr + ei; cr = nr; ci = ni;
                }
                __threadfence();
            }
            VM_WAIT(); __syncthreads();
            { pg8::Gemm g{AEXT, S5BT, 384, 384, 384}; pg8::SingleUnit S{unit, g_}; pg8::EpiS5Out E{AEXT, YACT, d_skip};
              pg8::gemm_phase<pg8::EpiS5Out, pg8::SingleUnit, false>(lds + RING_OFF, g, S, E); }
        }
        for (int blk = gw; blk < M / 16; blk += NGW) {
            const int w = 2 << (lane >> 4);
            for (int rr = 0; rr < 16; ++rr) {
                const int r = blk * 16 + rr, l = r & (SEQ - 1);
                const int cnt = (l + 1) < w ? (l + 1) : w;
                float a[8];
#pragma unroll
                for (int e = 0; e < 8; ++e) a[e] = 0.f;
                float s0[8];
                for (int j = 0; j < 16; ++j) {
                    if (j < cnt) { const v4u qw = *(const v4u*)(QB + (size_t)(r - j) * 512 + 8 * lane);
                        float f[8]; f[0] = pg8::bf_lo(qw.x); f[1] = pg8::bf_hi(qw.x); f[2] = pg8::bf_lo(qw.y); f[3] = pg8::bf_hi(qw.y); f[4] = pg8::bf_lo(qw.z); f[5] = pg8::bf_hi(qw.z); f[6] = pg8::bf_lo(qw.w); f[7] = pg8::bf_hi(qw.w);
#pragma unroll
                        for (int e = 0; e < 8; ++e) { a[e] += f[e]; if (j == 0) s0[e] = f[e]; } }
                }
                const float ic = 1.0f / (float)cnt; float q = 0.f;
#pragma unroll
                for (int e = 0; e < 8; ++e) { a[e] = a[e] * ic - s0[e]; q += a[e] * a[e]; }
                q = wave_sum(q);
                const float rs = rsqrtf(q * (1.0f / 512.0f) + pg8::RMS_EPS);
                v4u o; o.x = cvt_pk_bf16(a[0] * rs, a[1] * rs); o.y = cvt_pk_bf16(a[2] * rs, a[3] * rs); o.z = cvt_pk_bf16(a[4] * rs, a[5] * rs); o.w = cvt_pk_bf16(a[6] * rs, a[7] * rs);
                *(v4u*)(A5 + (size_t)r * 1024 + 512 + 8 * lane) = o;
            }
        }
    }
    SEAM(4);
    if (IN(5)) {
        pg8::Gemm g{YACT, WGLU, SW, SW, SW}; pg8::StaticOrder S; S.init(M, SW, G, bx); pg8::EpiGlu E{YACT, A5, b_glu, SSS};
        pg8::gemm_phase<pg8::EpiGlu, pg8::StaticOrder, true>(lds + RING_OFF, g, S, E);
    }
    SEAM(5);
    if (IN(6)) {
        pg8::Gemm g{A5, WO, D, D, D}; pg8::StaticOrder S; S.init(M, D, G, bx); pg8::EpiResid<true> E{out, out, HB, SS2, SSS, 1.0f / 512.0f};
        pg8::gemm_phase<pg8::EpiResid<true>, pg8::StaticOrder, true>(lds + RING_OFF, g, S, E);
    }
    SEAM(6);
    if (IN(7)) {
        pg8::Gemm g{HB, W13B, D, D, D}; pg8::StaticOrder S; S.init(M, NFF2, G, bx); pg8::EpiSwiGLU<16> E{ACT, FF, SS2, 1.0f / 1024.0f};
        pg8::gemm_phase<pg8::EpiSwiGLU<16>, pg8::StaticOrder, true>(lds + RING_OFF, g, S, E);
    }
    SEAM(7);
    if (IN(8)) {
        pg8::Gemm g{ACT, W2B, FF, FF, FF}; pg8::StaticOrder S; S.init(M, D, G, bx); pg8::EpiResid<false> E{out, out, HB, SS3, nullptr, 0.f};
        pg8::gemm_phase<pg8::EpiResid<false>, pg8::StaticOrder, true>(lds + RING_OFF, g, S, E);
    }
    SEAM(8);
    if (IN(9)) {
        pg8::Gemm g{HB, WG, D, D, D}; pg8::StaticOrder S; S.init(M, D, G, bx); pg8::EpiGate E{out, EB, SS3, SSE, ple_norm, SS4};
        pg8::gemm_phase<pg8::EpiGate, pg8::StaticOrder, true>(lds + RING_OFF, g, S, E);
    }
    SEAM(9);
    if (IN(10)) {
        for (int r = gw; r < M; r += NGW) {
            const float rs = pg8::row_rstd<16>(SS4, r, 1.0f / 1024.0f);
            f32x4* o = (f32x4*)(out + (size_t)r * D) + lane; const f32x4* gn = (const f32x4*)final_norm + lane;
#pragma unroll
            for (int j = 0; j < 4; ++j) { f32x4 v = o[64 * j]; const f32x4 gg = gn[64 * j]; v = v * rs * gg; o[64 * j] = v; }
        }
    }
#undef IN
#undef SEAM
}

extern "C" void kernel_launch(void* const* d_in, const int* in_sizes, int n_in, void* d_out, int out_size, void* d_ws, size_t ws_size, hipStream_t stream) {
    static int grid = 0;
    if (grid == 0) {
        if (n_in != 32 || in_sizes[0] != M * D || out_size != M * D || ws_size < WS_END) { fprintf(stderr, "kernel_launch: unexpected shapes (n_in %d, in0 %d, out %d, ws %zu)\n", n_in, n_in > 0 ? in_sizes[0] : -1, out_size, ws_size); grid = -1; return; }
        int dev = 0, cus = 0, per_cu = 0;
        if (hipGetDevice(&dev) != hipSuccess || hipDeviceGetAttribute(&cus, hipDeviceAttributeMultiprocessorCount, dev) != hipSuccess) { grid = -1; return; }
        if (hipFuncSetAttribute((const void*)hymba_fwd, hipFuncAttributeMaxDynamicSharedMemorySize, LDS_BYTES) != hipSuccess) { fprintf(stderr, "kernel_launch: hipFuncSetAttribute failed\n"); grid = -1; return; }
        if (hipOccupancyMaxActiveBlocksPerMultiprocessor(&per_cu, (const void*)hymba_fwd, NWAVES * 64, LDS_BYTES) != hipSuccess || per_cu < 1)
            fprintf(stderr, "kernel_launch: occupancy query reports %d workgroups per CU\n", per_cu);
        (void)hipGetLastError();
        grid = cus;
    }
    if (grid < 0) return;
    if (hipMemsetAsync((char*)d_ws + WS_CTL, 0, CTL_ZERO_BYTES, stream) != hipSuccess) { fprintf(stderr, "kernel_launch: memset failed\n"); return; }
    Args a{};
    for (int i = 0; i < 32; ++i) a.in[i] = (const float*)d_in[i];
    a.out = (float*)d_out; a.ws = (unsigned char*)d_ws;
    if (N_LAUNCHES == 1) { a.ph_lo = 0; a.ph_hi = NPHASE; a.li = 0; hipLaunchKernelGGL(hymba_fwd, dim3(grid), dim3(NWAVES * 64), LDS_BYTES, stream, a); }
    else for (int li = 0; li < NPHASE; ++li) { a.ph_lo = li; a.ph_hi = li + 1; a.li = 0; hipLaunchKernelGGL(hymba_fwd, dim3(grid), dim3(NWAVES * 64), LDS_BYTES, stream, a); }
    const hipError_t le = hipPeekAtLastError();
    if (le != hipSuccess) fprintf(stderr, "kernel_launch: launch failed: %s\n", hipGetErrorName(le));
}
```

```cpp
#include <hip/hip_runtime.h>
#include <cstdio>
#include <cstdint>

#ifndef MK_N_LAUNCHES
#define MK_N_LAUNCHES 1
#endif

namespace pg8 {
#define PG8_LAS __attribute__((address_space(3)))
typedef unsigned short bf16_t;
typedef short bf16x8 __attribute__((ext_vector_type(8)));
typedef float f32x4 __attribute__((ext_vector_type(4)));
typedef float f32x2 __attribute__((ext_vector_type(2)));
typedef unsigned u32x4 __attribute__((ext_vector_type(4)));
typedef unsigned u32x2 __attribute__((ext_vector_type(2)));
constexpr int BM = 256, BK = 64, HALF = 128, HTB = HALF * BK * 2, STAGE_BYTES = 8 * HTB, NXCD = 8, WGM = 8;

__host__ __device__ __forceinline__ int lds_byte(int r, int c) { const int st = (r >> 4) * 2 + (c >> 5), rr = r & 15, cc = c & 31, ob = rr * 64 + cc * 2; return st * 1024 + (ob ^ (((ob >> 9) & 1) << 5)); }
__host__ __device__ __forceinline__ void stage_rc(int b, int& R, int& C) { const int st = b / 1024, sb = b % 1024, swz = sb ^ (((sb >> 9) & 1) << 5); R = (st >> 1) * 16 + swz / 64; C = (st & 1) * 32 + (swz % 64) / 2; }
__host__ __device__ __forceinline__ int perm32(int rho) { const int n = rho >> 4, i = rho & 15; return 8 * (i >> 2) + 4 * n + (i & 3); }

struct Unit { int pm, pn; };
struct Gemm { const bf16_t* A; const bf16_t* Bt; int lda, ldb, K; };

struct StaticOrder {
    int nM, nN, nwg, G, c;
    __device__ void init(int M, int N, int G_, int c_) { nM = M / BM; nN = N / BM; nwg = nM * nN; G = G_; c = c_; }
    __device__ bool next(int i, Unit& u) const {
        const long L = (long)i * G + c; if (L >= nwg) return false;
        int wgid = (int)L; { const int q = nwg / NXCD, r = nwg % NXCD, xcd = wgid % NXCD, off = wgid / NXCD; wgid = (xcd < r ? xcd * (q + 1) : r * (q + 1) + (xcd - r) * q) + off; }
        const int nig = WGM * nN, gid = wgid / nig, fm = gid * WGM, gsz = (nM - fm) < WGM ? (nM - fm) : WGM;
        u.pm = fm + ((wgid % nig) % gsz); u.pn = (wgid % nig) / gsz; return true;
    }
};
struct SingleUnit {
    int pm, pn;
    __device__ bool next(int i, Unit& u) const { if (i > 0) return false; u.pm = pm; u.pn = pn; return true; }
};

__device__ __forceinline__ unsigned cvt_pk_bf16(float lo, float hi) { unsigned r; asm volatile("v_cvt_pk_bf16_f32 %0, %1, %2" : "=v"(r) : "v"(lo), "v"(hi)); return r; }
__device__ __forceinline__ float bf_lo(unsigned w) { return __uint_as_float(w << 16); }
__device__ __forceinline__ float bf_hi(unsigned w) { return __uint_as_float(w & 0xffff0000u); }
__device__ __forceinline__ float sigm(float x) { return __builtin_amdgcn_rcpf(1.0f + __expf(-x)); }
constexpr float RMS_EPS = 1e-6f;
template <int NP> __device__ __forceinline__ float row_rstd(const float* ss, int r, float inv_n) {
    float s = 0.f;
    if constexpr (NP == 1) s = ss[r];
    else {
#pragma unroll
        for (int i = 0; i < NP / 4; ++i) { const f32x4 v = *(const f32x4*)(ss + (size_t)r * NP + 4 * i); s += (v[0] + v[1]) + (v[2] + v[3]); }
    }
    return rsqrtf(s * inv_n + RMS_EPS);
}
__device__ __forceinline__ float quad_sum(float q) { q += __shfl_xor(q, 16); q += __shfl_xor(q, 32); return q; }

#define EPI_ROW_LOOP _Pragma("unroll") for (int ai = 0; ai < 2; ++ai) _Pragma("unroll") for (int m = 0; m < 4; ++m)
#define EPI_ROW (u.pm * BM + ai * HALF + wr * 64 + m * 16 + fr)

template <int NP> struct EpiSwiGLU {
    static constexpr bool PERM = true, AFTER_DRAIN = false, MIDSCALE = false;
    bf16_t* O; int ldo; const float* ss; float inv_n;
    __device__ __forceinline__ void operator()(const f32x4 (&acc)[2][2][4][2], const Unit& u, int wr, int wc, int fr, int fq) const {
        const int col0 = u.pn * HALF + wc * 32 + 8 * fq;
        EPI_ROW_LOOP { const int r = EPI_ROW;
            const float rs = row_rstd<NP>(ss, r, inv_n);
            float o[8];
#pragma unroll
            for (int n = 0; n < 2; ++n)
#pragma unroll
                for (int j = 0; j < 4; ++j) { const float a = acc[ai][0][m][n][j] * rs, b = acc[ai][1][m][n][j] * rs; o[4 * n + j] = a * sigm(a) * b; }
            u32x4 w; w.x = cvt_pk_bf16(o[0], o[1]); w.y = cvt_pk_bf16(o[2], o[3]); w.z = cvt_pk_bf16(o[4], o[5]); w.w = cvt_pk_bf16(o[6], o[7]);
            *(u32x4*)(O + (size_t)r * ldo + col0) = w;
        }
    }
    __device__ __forceinline__ void midscale(f32x4 (&)[2][2][4][2], const Unit&, int, int) const {}
};

template <bool MID> struct EpiResid {
    static constexpr bool PERM = true, AFTER_DRAIN = false, MIDSCALE = MID;
    bf16_t* hb; float* ssout; const float* ssmid; float inv_mid;
    __device__ __forceinline__ void operator()(const f32x4 (&acc)[2][2][4][2], const Unit& u, int wr, int wc, int fr, int fq) const {
        const int colb = u.pn * BM + wc * 32 + 8 * fq;
        EPI_ROW_LOOP { const int r = EPI_ROW;
            float q = 0.f;
#pragma unroll
            for (int bj = 0; bj < 2; ++bj) {
                const size_t off = (size_t)r * 1024 + colb + bj * HALF;
                const u32x4 hw = *(const u32x4*)(hb + off);
                float v[8];
                v[0] = bf_lo(hw.x) + acc[ai][bj][m][0][0]; v[1] = bf_hi(hw.x) + acc[ai][bj][m][0][1]; v[2] = bf_lo(hw.y) + acc[ai][bj][m][0][2]; v[3] = bf_hi(hw.y) + acc[ai][bj][m][0][3];
                v[4] = bf_lo(hw.z) + acc[ai][bj][m][1][0]; v[5] = bf_hi(hw.z) + acc[ai][bj][m][1][1]; v[6] = bf_lo(hw.w) + acc[ai][bj][m][1][2]; v[7] = bf_hi(hw.w) + acc[ai][bj][m][1][3];
#pragma unroll
                for (int j = 0; j < 8; ++j) q += v[j] * v[j];
                u32x4 w; w.x = cvt_pk_bf16(v[0], v[1]); w.y = cvt_pk_bf16(v[2], v[3]); w.z = cvt_pk_bf16(v[4], v[5]); w.w = cvt_pk_bf16(v[6], v[7]);
                *(u32x4*)(hb + off) = w;
            }
            q = quad_sum(q);
            if (fq == 0) ssout[(size_t)r * 16 + u.pn * 4 + wc] = q;
        }
    }
    __device__ __forceinline__ void midscale(f32x4 (&acc)[2][2][4][2], const Unit& u, int wr, int fr) const {
        EPI_ROW_LOOP { const int r = EPI_ROW;
            const float rs = row_rstd<8>(ssmid, r, inv_mid);
#pragma unroll
            for (int bj = 0; bj < 2; ++bj)
#pragma unroll
                for (int n = 0; n < 2; ++n) acc[ai][bj][m][n] *= rs;
        }
    }
};

struct EpiWin {
    static constexpr bool PERM = true, AFTER_DRAIN = false, MIDSCALE = false;
    bf16_t* Aext; bf16_t* Q; const float* ss;
    __device__ __forceinline__ void operator()(const f32x4 (&acc)[2][2][4][2], const Unit& u, int wr, int wc, int fr, int fq) const {
        EPI_ROW_LOOP { const int r = EPI_ROW;
            const float rs = row_rstd<16>(ss, r, 1.0f / 1024.0f);
#pragma unroll
            for (int bj = 0; bj < 2; ++bj) {
                const f32x4 v0 = acc[ai][bj][m][0] * rs, v1 = acc[ai][bj][m][1] * rs;
                u32x4 w; w.x = cvt_pk_bf16(v0[0], v0[1]); w.y = cvt_pk_bf16(v0[2], v0[3]); w.z = cvt_pk_bf16(v1[0], v1[1]); w.w = cvt_pk_bf16(v1[2], v1[3]);
                const int c0 = (u.pn & 1) * BM + bj * HALF + wc * 32 + 8 * fq;
                if (u.pn < 2) { const int g = c0 >> 4, q0 = c0 & 15, b = r >> 12, l = r & 4095;
                    *(u32x4*)(Aext + ((size_t)((g * 8 + b) * 256 + (l >> 4))) * 384 + 128 + (l & 15) * 16 + q0) = w; }
                else *(u32x4*)(Q + (size_t)r * 512 + c0) = w;
            }
        }
    }
    __device__ __forceinline__ void midscale(f32x4 (&)[2][2][4][2], const Unit&, int, int) const {}
};

struct EpiGlu {
    static constexpr bool PERM = true, AFTER_DRAIN = false, MIDSCALE = false;
    const bf16_t* Y; bf16_t* A5; const float* bias; float* ssout;
    __device__ __forceinline__ void operator()(const f32x4 (&acc)[2][2][4][2], const Unit& u, int wr, int wc, int fr, int fq) const {
        const int colb = u.pn * BM + wc * 32 + 8 * fq;
        f32x4 bv[2][2];
#pragma unroll
        for (int bj = 0; bj < 2; ++bj)
#pragma unroll
            for (int n = 0; n < 2; ++n) bv[bj][n] = *(const f32x4*)(bias + colb + bj * HALF + 4 * n);
        EPI_ROW_LOOP { const int r = EPI_ROW;
            float q = 0.f;
#pragma unroll
            for (int bj = 0; bj < 2; ++bj) {
                const int c0 = colb + bj * HALF;
                const u32x4 yw = *(const u32x4*)(Y + (size_t)r * 512 + c0);
                const f32x4 g0 = acc[ai][bj][m][0] + bv[bj][0], g1 = acc[ai][bj][m][1] + bv[bj][1];
                float o[8];
                o[0] = bf_lo(yw.x) * sigm(g0[0]); o[1] = bf_hi(yw.x) * sigm(g0[1]); o[2] = bf_lo(yw.y) * sigm(g0[2]); o[3] = bf_hi(yw.y) * sigm(g0[3]);
                o[4] = bf_lo(yw.z) * sigm(g1[0]); o[5] = bf_hi(yw.z) * sigm(g1[1]); o[6] = bf_lo(yw.w) * sigm(g1[2]); o[7] = bf_hi(yw.w) * sigm(g1[3]);
#pragma unroll
                for (int j = 0; j < 8; ++j) q += o[j] * o[j];
                u32x4 w; w.x = cvt_pk_bf16(o[0], o[1]); w.y = cvt_pk_bf16(o[2], o[3]); w.z = cvt_pk_bf16(o[4], o[5]); w.w = cvt_pk_bf16(o[6], o[7]);
                *(u32x4*)(A5 + (size_t)r * 1024 + c0) = w;
            }
            q = quad_sum(q);
            if (fq == 0) ssout[(size_t)r * 8 + u.pn * 4 + wc] = q;
        }
    }
    __device__ __forceinline__ void midscale(f32x4 (&)[2][2][4][2], const Unit&, int, int) const {}
};

struct EpiEmb {
    static constexpr bool PERM = true, AFTER_DRAIN = false, MIDSCALE = false;
    bf16_t* E; float* ssout;
    __device__ __forceinline__ void operator()(const f32x4 (&acc)[2][2][4][2], const Unit& u, int wr, int wc, int fr, int fq) const {
        const int colb = u.pn * BM + wc * 32 + 8 * fq;
        EPI_ROW_LOOP { const int r = EPI_ROW;
            float q = 0.f;
#pragma unroll
            for (int bj = 0; bj < 2; ++bj) {
                const f32x4 v0 = acc[ai][bj][m][0], v1 = acc[ai][bj][m][1];
                q += (v0[0] * v0[0] + v0[1] * v0[1]) + (v0[2] * v0[2] + v0[3] * v0[3]) + (v1[0] * v1[0] + v1[1] * v1[1]) + (v1[2] * v1[2] + v1[3] * v1[3]);
                u32x4 w; w.x = cvt_pk_bf16(v0[0], v0[1]); w.y = cvt_pk_bf16(v0[2], v0[3]); w.z = cvt_pk_bf16(v1[0], v1[1]); w.w = cvt_pk_bf16(v1[2], v1[3]);
                *(u32x4*)(E + (size_t)r * 1024 + colb + bj * HALF) = w;
            }
            q = quad_sum(q);
            if (fq == 0) ssout[(size_t)r * 16 + u.pn * 4 + wc] = q;
        }
    }
    __device__ __forceinline__ void midscale(f32x4 (&)[2][2][4][2], const Unit&, int, int) const {}
};

struct EpiGate {
    static constexpr bool PERM = true, AFTER_DRAIN = false, MIDSCALE = false;
    float* out; const bf16_t* hb; const bf16_t* E; const float* ss3; const float* sse; const float* gple; float* ssout;
    __device__ __forceinline__ void operator()(const f32x4 (&acc)[2][2][4][2], const Unit& u, int wr, int wc, int fr, int fq) const {
        const int colb = u.pn * BM + wc * 32 + 8 * fq;
        EPI_ROW_LOOP { const int r = EPI_ROW;
            const float rs3 = row_rstd<16>(ss3, r, 1.0f / 1024.0f), rse = row_rstd<16>(sse, r, 1.0f / 1024.0f);
            float q = 0.f;
#pragma unroll
            for (int bj = 0; bj < 2; ++bj) {
                const int c0 = colb + bj * HALF; const size_t off = (size_t)r * 1024 + c0;
                const u32x4 ew = *(const u32x4*)(E + off);
                const f32x4 gp0 = *(const f32x4*)(gple + c0), gp1 = *(const f32x4*)(gple + c0 + 4);
                const u32x4 hw = *(const u32x4*)(hb + off);
                const f32x4 h0 = (f32x4){bf_lo(hw.x), bf_hi(hw.x), bf_lo(hw.y), bf_hi(hw.y)}, h1 = (f32x4){bf_lo(hw.z), bf_hi(hw.z), bf_lo(hw.w), bf_hi(hw.w)};
                const f32x4 a0 = acc[ai][bj][m][0] * rs3, a1 = acc[ai][bj][m][1] * rs3;
                f32x4 o0, o1;
                o0[0] = h0[0] + sigm(a0[0]) * (bf_lo(ew.x) * rse * gp0[0]); o0[1] = h0[1] + sigm(a0[1]) * (bf_hi(ew.x) * rse * gp0[1]);
                o0[2] = h0[2] + sigm(a0[2]) * (bf_lo(ew.y) * rse * gp0[2]); o0[3] = h0[3] + sigm(a0[3]) * (bf_hi(ew.y) * rse * gp0[3]);
                o1[0] = h1[0] + sigm(a1[0]) * (bf_lo(ew.z) * rse * gp1[0]); o1[1] = h1[1] + sigm(a1[1]) * (bf_hi(ew.z) * rse * gp1[1]);
                o1[2] = h1[2] + sigm(a1[2]) * (bf_lo(ew.w) * rse * gp1[2]); o1[3] = h1[3] + sigm(a1[3]) * (bf_hi(ew.w) * rse * gp1[3]);
                q += (o0[0] * o0[0] + o0[1] * o0[1]) + (o0[2] * o0[2] + o0[3] * o0[3]) + (o1[0] * o1[0] + o1[1] * o1[1]) + (o1[2] * o1[2] + o1[3] * o1[3]);
                *(f32x4*)(out + off) = o0; *(f32x4*)(out + off + 4) = o1;
            }
            q = quad_sum(q);
            if (fq == 0) ssout[(size_t)r * 16 + u.pn * 4 + wc] = q;
        }
    }
    __device__ __forceinline__ void midscale(f32x4 (&)[2][2][4][2], const Unit&, int, int) const {}
};

struct EpiS5End {
    static constexpr bool PERM = false, AFTER_DRAIN = true, MIDSCALE = false;
    __device__ __forceinline__ void fused(f32x4 (&acc)[2][2][4][2], const Unit&, int wr, int wc, int fr, int fq, PG8_LAS unsigned char* lds, int, int) const {
        PG8_LAS float* El = (PG8_LAS float*)lds;
#pragma unroll
        for (int ai = 0; ai < 2; ++ai)
#pragma unroll
            for (int m = 0; m < 4; ++m) { const int c = ai * HALF + wr * 64 + m * 16 + fr;
#pragma unroll
                for (int n = 0; n < 2; ++n) *(PG8_LAS f32x4*)(El + c * 128 + wc * 32 + n * 16 + 4 * fq) = acc[ai][0][m][n]; }
    }
    __device__ __forceinline__ void midscale(f32x4 (&)[2][2][4][2], const Unit&, int, int) const {}
};

struct EpiS5Out {
    static constexpr bool PERM = true, AFTER_DRAIN = false, MIDSCALE = false;
    const bf16_t* Aext; bf16_t* Y; const float* dskip;
    __device__ __forceinline__ void operator()(const f32x4 (&acc)[2][2][4][2], const Unit& u, int wr, int wc, int fr, int fq) const {
        const int g = u.pn, b = u.pm & 7;
        const int p0 = (8 * fq) & 15;
        const f32x4 d0 = *(const f32x4*)(dskip + g * 16 + p0), d1 = *(const f32x4*)(dskip + g * 16 + p0 + 4);
#pragma unroll
        for (int ai = 0; ai < 2; ++ai)
#pragma unroll
            for (int m = 0; m < 4; ++m) { const int c = ai * HALF + wr * 64 + m * 16 + fr;
#pragma unroll
                for (int bj = 0; bj < 2; ++bj) {
                    const int cl = bj * HALF + wc * 32 + 8 * fq, t = cl >> 4;
                    const u32x4 uw = *(const u32x4*)(Aext + ((size_t)u.pm * 256 + c) * 384 + 128 + cl);
                    float v[8];
                    v[0] = acc[ai][bj][m][0][0] + d0[0] * bf_lo(uw.x); v[1] = acc[ai][bj][m][0][1] + d0[1] * bf_hi(uw.x);
                    v[2] = acc[ai][bj][m][0][2] + d0[2] * bf_lo(uw.y); v[3] = acc[ai][bj][m][0][3] + d0[3] * bf_hi(uw.y);
                    v[4] = acc[ai][bj][m][1][0] + d1[0] * bf_lo(uw.z); v[5] = acc[ai][bj][m][1][1] + d1[1] * bf_hi(uw.z);
                    v[6] = acc[ai][bj][m][1][2] + d1[2] * bf_lo(uw.w); v[7] = acc[ai][bj][m][1][3] + d1[3] * bf_hi(uw.w);
#pragma unroll
                    for (int j = 0; j < 8; ++j) { const float x = v[j]; v[j] = x * sigm(1.5957691216f * (x + 0.044715f * x * x * x)); }
                    u32x4 w; w.x = cvt_pk_bf16(v[0], v[1]); w.y = cvt_pk_bf16(v[2], v[3]); w.z = cvt_pk_bf16(v[4], v[5]); w.w = cvt_pk_bf16(v[6], v[7]);
                    *(u32x4*)(Y + ((size_t)b * 4096 + c * 16 + t) * 512 + g * 16 + p0) = w;
                } }
    }
    __device__ __forceinline__ void midscale(f32x4 (&)[2][2][4][2], const Unit&, int, int) const {}
};

template <class Epi, class Sched, bool ALIGN_EPI = false, bool SP2 = true>
__device__ __forceinline__ void gemm_phase(PG8_LAS unsigned char* lds, const Gemm g, const Sched& S, const Epi& E) {
    const int tid = threadIdx.x, wid = __builtin_amdgcn_readfirstlane(tid >> 6), lane = tid & 63, wr = wid >> 2, wc = wid & 3, fr = lane & 15, fq = lane >> 4;
    int nt = g.K / BK; asm volatile("" : "+s"(nt));
    unsigned voffA[2], voffB[2];
#pragma unroll
    for (int i = 0; i < 2; ++i) { int R, C; stage_rc(tid * 16 + i * 8192, R, C); const int Rb = Epi::PERM ? ((R & ~31) + perm32(R & 31)) : R;
        voffA[i] = (unsigned)(R * g.lda + C) * 2u; voffB[i] = (unsigned)(Rb * g.ldb + C) * 2u; }
    const size_t kstep = (size_t)(BK * 2);
    const size_t hstepA = (size_t)HALF * g.lda * 2, hstepB = (size_t)HALF * g.ldb * 2;
    const size_t tstepA = 2 * hstepA, tstepB = 2 * hstepB;
    const unsigned ldsw = (unsigned)wid * 1024u;
    const int aoff = lds_byte(wr * 64 + fr, fq * 8), boff = lds_byte(wc * 32 + fr, fq * 8);
#define PG8_SA(b, h) (((b) * 2 + (h)) * HTB)
#define PG8_SB(b, h) ((4 + (b) * 2 + (h)) * HTB)
#define PG8_STAGE(bufoff, gbase, voff) do { _Pragma("unroll") for (int _i = 0; _i < 2; ++_i) \
        __builtin_amdgcn_global_load_lds((const unsigned*)((const char*)(gbase) + (voff)[_i]), (PG8_LAS unsigned*)(lds + (bufoff) + ldsw + _i * 8192), 16, 0, 0); } while (0)
#define PG8_LDA(dst, b, h) do { _Pragma("unroll") for (int m = 0; m < 4; ++m) _Pragma("unroll") for (int k = 0; k < 2; ++k) dst[m][k] = *(const PG8_LAS bf16x8*)(lds + PG8_SA(b, h) + aoff + m * 2048 + k * 1024); } while (0)
#define PG8_LDB(dst, b, h) do { _Pragma("unroll") for (int n = 0; n < 2; ++n) _Pragma("unroll") for (int k = 0; k < 2; ++k) dst[n][k] = *(const PG8_LAS bf16x8*)(lds + PG8_SB(b, h) + boff + n * 2048 + k * 1024); } while (0)
#define PG8_MMA(ai, bj, At, Bt) do { __builtin_amdgcn_s_setprio(1); _Pragma("unroll") for (int m = 0; m < 4; ++m) _Pragma("unroll") for (int n = 0; n < 2; ++n) _Pragma("unroll") for (int k = 0; k < 2; ++k) \
        acc[ai][bj][m][n] = __builtin_amdgcn_mfma_f32_16x16x32_bf16(Bt[n][k], At[m][k], acc[ai][bj][m][n], 0, 0, 0); __builtin_amdgcn_s_setprio(0); } while (0)
#define PG8_WAIT_V(n) asm volatile("s_waitcnt vmcnt(" #n ")" ::: "memory")
#define PG8_WAIT_L(n) asm volatile("s_waitcnt lgkmcnt(" #n ")" ::: "memory")
#define PG8_BAR __builtin_amdgcn_s_barrier()
#define PG8_SCHED __builtin_amdgcn_sched_barrier(0)
    Unit cur, nxt; int ui = 0;
    if (!S.next(0, cur)) return;
    f32x4 acc[2][2][4][2];
#pragma unroll
    for (int a = 0; a < 2; ++a)
#pragma unroll
        for (int b = 0; b < 2; ++b)
#pragma unroll
            for (int m = 0; m < 4; ++m)
#pragma unroll
                for (int n = 0; n < 2; ++n) acc[a][b][m][n] = (f32x4){0.f, 0.f, 0.f, 0.f};
    bf16x8 At[4][2], B0[2][2], B1[2][2];
    const char* cA = (const char*)g.A + (size_t)cur.pm * tstepA; const char* cB = (const char*)g.Bt + (size_t)cur.pn * tstepB;
    if constexpr (SP2) {
        PG8_STAGE(PG8_SB(0, 0), cB, voffB); PG8_STAGE(PG8_SB(0, 1), cB + hstepB, voffB); PG8_STAGE(PG8_SA(0, 0), cA, voffA); PG8_STAGE(PG8_SA(0, 1), cA + hstepA, voffA);
        if (wr == 1) PG8_BAR;
        PG8_WAIT_V(2); PG8_BAR;
        PG8_STAGE(PG8_SB(1, 0), cB + kstep, voffB); PG8_STAGE(PG8_SA(1, 0), cA + kstep, voffA); PG8_STAGE(PG8_SB(1, 1), cB + hstepB + kstep, voffB);
        PG8_WAIT_V(6); PG8_BAR;
    } else {
        PG8_STAGE(PG8_SB(0, 0), cB, voffB); PG8_STAGE(PG8_SA(0, 0), cA, voffA); PG8_STAGE(PG8_SB(0, 1), cB + hstepB, voffB); PG8_STAGE(PG8_SA(0, 1), cA + hstepA, voffA);
        if (wr == 1) PG8_BAR;
        PG8_WAIT_V(4); PG8_BAR;
        PG8_STAGE(PG8_SB(1, 0), cB + kstep, voffB); PG8_STAGE(PG8_SA(1, 0), cA + kstep, voffA); PG8_STAGE(PG8_SB(1, 1), cB + hstepB + kstep, voffB);
        PG8_WAIT_V(6); PG8_BAR;
    }
    for (;;) {
        const bool has_next = S.next(ui + 1, nxt);
        const char* nA = has_next ? (const char*)g.A + (size_t)nxt.pm * tstepA : cA; const char* nB = has_next ? (const char*)g.Bt + (size_t)nxt.pn * tstepB : cB;
        for (int t = 0; t < nt; t += 2) {
            const bool last = (t == nt - 2);
            const char* a1 = cA + (size_t)(t + 1) * kstep;
            const char* a2 = last ? nA : cA + (size_t)(t + 2) * kstep; const char* b2 = last ? nB : cB + (size_t)(t + 2) * kstep;
            const char* a3 = a2 + kstep; const char* b3 = b2 + kstep;
            if constexpr (Epi::MIDSCALE) { if (t == (nt >> 1)) E.midscale(acc, cur, wr, fr); }
            if constexpr (SP2) {
            PG8_LDB(B0, 0, 0); PG8_LDB(B1, 0, 1); PG8_SCHED; PG8_LDA(At, 0, 0); PG8_STAGE(PG8_SA(1, 1), a1 + hstepA, voffA);
            PG8_WAIT_V(8); PG8_WAIT_L(0); PG8_BAR; PG8_MMA(0, 0, At, B0); PG8_MMA(0, 1, At, B1); PG8_BAR; PG8_SCHED;
            PG8_LDA(At, 0, 1); PG8_STAGE(PG8_SB(0, 0), b2, voffB); PG8_STAGE(PG8_SB(0, 1), b2 + hstepB, voffB); PG8_STAGE(PG8_SA(0, 0), a2, voffA);
            PG8_WAIT_V(8); PG8_WAIT_L(0); PG8_BAR; PG8_MMA(1, 0, At, B0); PG8_MMA(1, 1, At, B1); PG8_BAR; PG8_SCHED;
            PG8_LDB(B0, 1, 0); PG8_LDB(B1, 1, 1); PG8_SCHED; PG8_LDA(At, 1, 0); PG8_STAGE(PG8_SA(0, 1), a2 + hstepA, voffA);
            PG8_WAIT_V(8); PG8_WAIT_L(0); PG8_BAR; PG8_MMA(0, 0, At, B0); PG8_MMA(0, 1, At, B1); PG8_BAR; PG8_SCHED;
            PG8_LDA(At, 1, 1); PG8_STAGE(PG8_SB(1, 0), b3, voffB); PG8_STAGE(PG8_SB(1, 1), b3 + hstepB, voffB); PG8_STAGE(PG8_SA(1, 0), a3, voffA);
            PG8_WAIT_V(8); PG8_WAIT_L(0); PG8_BAR; PG8_MMA(1, 0, At, B0); PG8_MMA(1, 1, At, B1); PG8_BAR; PG8_SCHED;
            } else {
            PG8_LDB(B0, 0, 0); PG8_SCHED; PG8_LDA(At, 0, 0); PG8_STAGE(PG8_SA(1, 1), a1 + hstepA, voffA);
            PG8_WAIT_L(8); PG8_BAR; PG8_WAIT_L(0); PG8_MMA(0, 0, At, B0); PG8_BAR; PG8_SCHED;
            PG8_LDB(B1, 0, 1); PG8_STAGE(PG8_SB(0, 0), b2, voffB);
            PG8_BAR; PG8_WAIT_L(0); PG8_MMA(0, 1, At, B1); PG8_BAR;
            PG8_LDA(At, 0, 1); PG8_STAGE(PG8_SA(0, 0), a2, voffA);
            PG8_BAR; PG8_WAIT_L(0); PG8_MMA(1, 0, At, B0); PG8_BAR; PG8_SCHED;
            PG8_STAGE(PG8_SB(0, 1), b2 + hstepB, voffB);
            PG8_WAIT_V(6); PG8_BAR; PG8_MMA(1, 1, At, B1); PG8_BAR;
            PG8_LDB(B0, 1, 0); PG8_SCHED; PG8_LDA(At, 1, 0); PG8_STAGE(PG8_SA(0, 1), a2 + hstepA, voffA);
            PG8_WAIT_L(8); PG8_BAR; PG8_WAIT_L(0); PG8_MMA(0, 0, At, B0); PG8_BAR; PG8_SCHED;
            PG8_LDB(B1, 1, 1); PG8_STAGE(PG8_SB(1, 0), b3, voffB);
            PG8_BAR; PG8_WAIT_L(0); PG8_MMA(0, 1, At, B1); PG8_BAR;
            PG8_LDA(At, 1, 1); PG8_STAGE(PG8_SA(1, 0), a3, voffA);
            PG8_BAR; PG8_WAIT_L(0); PG8_MMA(1, 0, At, B0); PG8_BAR; PG8_SCHED;
            PG8_STAGE(PG8_SB(1, 1), b3 + hstepB, voffB);
            PG8_WAIT_V(6); PG8_BAR; PG8_MMA(1, 1, At, B1); PG8_BAR;
            }
        }
        if constexpr (ALIGN_EPI) { if (wr == 0) PG8_BAR; }
        if constexpr (!Epi::AFTER_DRAIN) { E(acc, cur, wr, wc, fr, fq); }
        if (!has_next) break;
#pragma unroll
        for (int a = 0; a < 2; ++a)
#pragma unroll
            for (int b = 0; b < 2; ++b)
#pragma unroll
                for (int m = 0; m < 4; ++m)
#pragma unroll
                    for (int n = 0; n < 2; ++n) acc[a][b][m][n] = (f32x4){0.f, 0.f, 0.f, 0.f};
        cur = nxt; cA = nA; cB = nB; ++ui;
        if constexpr (ALIGN_EPI) { if (wr == 1) PG8_BAR; }
    }
    PG8_WAIT_V(0);
    if constexpr (!ALIGN_EPI) { if (wr == 0) PG8_BAR; }
    PG8_BAR;
    if constexpr (Epi::AFTER_DRAIN) { E.fused(acc, cur, wr, wc, fr, fq, lds, wid, lane); }
#undef PG8_SA
#undef PG8_SB
#undef PG8_STAGE
#undef PG8_LDA
#undef PG8_LDB
#undef PG8_MMA
#undef PG8_WAIT_V
#undef PG8_WAIT_L
#undef PG8_BAR
#undef PG8_SCHED
}
}

constexpr int NWAVES = 8;
constexpr int N_LAUNCHES = MK_N_LAUNCHES;
constexpr int NPHASE = 11;
constexpr int M = 32768, D = 1024, FF = 2816, NFF2 = 2 * FF, SW = 512, PLE = 256, SEQ = 4096;
constexpr int NG = 32, NS = 64, GP = 16;
constexpr size_t MiB = 1u << 20;
constexpr size_t WS_CTL = 0, CTL_ZERO_BYTES = 1 * MiB;
constexpr size_t WS_W13A = 2 * MiB, WS_W2A = 13 * MiB, WS_W13B = 19 * MiB, WS_W2B = 30 * MiB;
constexpr size_t WS_WIN = 36 * MiB, WS_WGLU = 38 * MiB, WS_WO = 39 * MiB, WS_WG = 41 * MiB, WS_WPP = 43 * MiB;
constexpr size_t WS_S5BT = 44 * MiB, WS_S5WE = 50 * MiB, WS_A16 = 54 * MiB;
constexpr size_t WS_SS0 = 56 * MiB, WS_SS1 = 58 * MiB, WS_SSS = 60 * MiB, WS_SS2 = 62 * MiB, WS_SS3 = 64 * MiB, WS_SSE = 66 * MiB, WS_SS4 = 68 * MiB;
constexpr size_t WS_HB = 72 * MiB, WS_PB = 136 * MiB, WS_E = 152 * MiB, WS_A5 = 216 * MiB, WS_ACT = 280 * MiB;
constexpr size_t WS_AEXT = WS_ACT, WS_Q = 328 * MiB, WS_YACT = 360 * MiB, WS_END = 456 * MiB;
static_assert(WS_W13A + (size_t)NFF2 * D * 2 <= WS_W2A && WS_W2A + (size_t)D * FF * 2 <= WS_W13B && WS_W13B + (size_t)NFF2 * D * 2 <= WS_W2B && WS_W2B + (size_t)D * FF * 2 <= WS_WIN, "ws map 1");
static_assert(WS_S5BT + (size_t)NG * 256 * 384 * 2 <= WS_S5WE && WS_S5WE + (size_t)NG * 256 * 256 * 2 <= WS_A16, "ws map 2");
static_assert(WS_ACT + (size_t)M * FF * 2 <= WS_END && WS_AEXT + (size_t)256 * 256 * 384 * 2 <= WS_Q && WS_Q + (size_t)M * 512 * 2 <= WS_YACT && WS_YACT + (size_t)M * 512 * 2 <= WS_END, "ws map 3");
constexpr int CW_BAR = 4096;
constexpr int RING_OFF = 0, RING_BYTES = 131072, LDSCTL_OFF = RING_BYTES, MISC_OFF = LDSCTL_OFF + 320, LDS_BYTES = 147456;

#define LAS __attribute__((address_space(3)))
typedef unsigned short bf16;
typedef unsigned v4u __attribute__((ext_vector_type(4)));
typedef unsigned v2u __attribute__((ext_vector_type(2)));
typedef float f32x4 __attribute__((ext_vector_type(4)));
#define LDS_WAIT() asm volatile("s_waitcnt lgkmcnt(0)" ::: "memory")
#define VM_WAIT() asm volatile("s_waitcnt vmcnt(0)" ::: "memory")
using pg8::cvt_pk_bf16;
__device__ __forceinline__ unsigned short f2bf(float f) { return (unsigned short)(cvt_pk_bf16(f, 0.f) & 0xffffu); }

#define XB_TMO      128
#define XB_XCNT(j)  (256  + 64 * (j))
#define XB_XSUB(j)  (1280 + 64 * (j))
#define XB_XGEN(j)  (2304 + 64 * (j))
#define XB_TOP      3328
#define XB_TOPGEN   3392
#define XCD_BAR_WORDS 3456
#define XB_SPIN_CAP (1u << 20)
__device__ __forceinline__ unsigned xb_ld(unsigned* p)              { return __hip_atomic_load(p, __ATOMIC_RELAXED, __HIP_MEMORY_SCOPE_AGENT); }
__device__ __forceinline__ unsigned xb_add(unsigned* p, unsigned v) { return __hip_atomic_fetch_add(p, v, __ATOMIC_RELAXED, __HIP_MEMORY_SCOPE_AGENT); }
__device__ __forceinline__ unsigned xb_xcc_id() { return (unsigned)__builtin_amdgcn_s_getreg((3 << 11) | 20) & 0xFu; }
#define XB_SPIN(cond, bar) do { unsigned _sp = 0; while (cond) { __builtin_amdgcn_s_sleep(1); \
    if ((++_sp & 255u) == 0u) { if (xb_ld(&(bar)[XB_TMO])) break; if (_sp > XB_SPIN_CAP) { atomicAdd(&(bar)[XB_TMO], 1u); break; } } } } while (0)
struct XcdBarrier { unsigned* bar; unsigned x; volatile LAS unsigned* st; };
__device__ __forceinline__ XcdBarrier xcd_barrier_post(unsigned* bar, volatile LAS unsigned* st) {
    XcdBarrier b; b.bar = bar; b.x = xb_xcc_id(); b.st = st;
    if (threadIdx.x == 0) (void)xb_add(&bar[XB_XCNT(b.x)], 1u);
    return b;
}
__device__ __forceinline__ void xcd_barrier_complete(unsigned* bar, unsigned x, unsigned& nloc, unsigned& nx) {
    const unsigned G = gridDim.x * gridDim.y * gridDim.z;
    unsigned sum, cnt, mine, sp = 0u;
    for (;;) {
        sum = 0u; cnt = 0u; mine = 0u;
#pragma unroll
        for (unsigned j = 0; j < 16; ++j) { const unsigned c = xb_ld(&bar[XB_XCNT(j)]); sum += c; cnt += (c > 0u) ? 1u : 0u; mine = (j == x) ? c : mine; }
        if (sum == G) break;
        __builtin_amdgcn_s_sleep(1);
        if ((++sp & 255u) == 0u) { if (xb_ld(&bar[XB_TMO])) break; if (sp > XB_SPIN_CAP) { atomicAdd(&bar[XB_TMO], 1u); break; } }
    }
    nloc = mine > 0u ? mine : 1u; nx = cnt > 0u ? cnt : 1u;
}
__device__ __forceinline__ void xcd_barrier(const XcdBarrier& b) {
    asm volatile("s_waitcnt vmcnt(0)" ::: "memory");
    __syncthreads();
    if (threadIdx.x == 0) {
        unsigned* bar = b.bar;
        __builtin_amdgcn_s_waitcnt(0);
        unsigned nloc = b.st[0], nx = b.st[1];
        if (nloc == 0u) { xcd_barrier_complete(bar, b.x, nloc, nx); b.st[0] = nloc; b.st[1] = nx; }
        const unsigned old = xb_add(&bar[XB_XSUB(b.x)], 1u);
        const unsigned gen = old / nloc;
        if (old + 1u == (gen + 1u) * nloc) {
            __builtin_amdgcn_fence(__ATOMIC_RELEASE, "agent");
            asm volatile("s_waitcnt vmcnt(0)" ::: "memory");
            const unsigned og = xb_add(&bar[XB_TOP], 1u);
            const unsigned tg = og / nx;
            if (og + 1u == (tg + 1u) * nx) xb_add(&bar[XB_TOPGEN], 1u);
            else XB_SPIN(xb_ld(&bar[XB_TOPGEN]) == tg, bar);
            __builtin_amdgcn_fence(__ATOMIC_ACQUIRE, "agent");
            xb_add(&bar[XB_XGEN(b.x)], 1u);
            asm volatile("s_waitcnt vmcnt(0)" ::: "memory");
        } else {
            XB_SPIN(xb_ld(&bar[XB_XGEN(b.x)]) == gen, bar);
            __builtin_amdgcn_fence(__ATOMIC_ACQUIRE, "agent");
            asm volatile("s_waitcnt vmcnt(0)" ::: "memory");
        }
    }
    __syncthreads();
}

__device__ __forceinline__ float wave_sum(float v) {
#pragma unroll
    for (int o = 1; o < 64; o <<= 1) v += __shfl_xor(v, o);
    return v;
}
__device__ __forceinline__ void transpose_item(const float* W, int K, int N, bf16* WT, int k0, int n0, int drow0, const float* gain, float scale, LAS float* scr, int lane) {
    f32x4 v[8]; float gk[8];
    const int rr = lane >> 3, c4 = 4 * (lane & 7);
#pragma unroll
    for (int i = 0; i < 8; ++i) { const int kk = i * 8 + rr; v[i] = *(const f32x4*)(W + (size_t)(k0 + kk) * N + n0 + c4); gk[i] = gain ? gain[k0 + kk] * scale : scale; }
#pragma unroll
    for (int i = 0; i < 8; ++i) { const int kk = i * 8 + rr; LAS float* d = scr + kk * 33 + c4; d[0] = v[i][0] * gk[i]; d[1] = v[i][1] * gk[i]; d[2] = v[i][2] * gk[i]; d[3] = v[i][3] * gk[i]; }
    LDS_WAIT(); asm volatile("" ::: "memory");
    const int c = lane & 7;
#pragma unroll
    for (int j = 0; j < 4; ++j) { const int n = (lane >> 3) + 8 * j; const LAS float* s = scr + (8 * c) * 33 + n;
        v4u o; o.x = cvt_pk_bf16(s[0 * 33], s[1 * 33]); o.y = cvt_pk_bf16(s[2 * 33], s[3 * 33]); o.z = cvt_pk_bf16(s[4 * 33], s[5 * 33]); o.w = cvt_pk_bf16(s[6 * 33], s[7 * 33]);
        *(v4u*)(WT + (size_t)(drow0 + n) * K + k0 + 8 * c) = o; }
    LDS_WAIT(); asm volatile("" ::: "memory");
}
__device__ __forceinline__ void cpow(float lr, float li, float dt, float e, float& pr, float& pi) {
    const float mag = expf(lr * dt * e); float s, c; sincosf(li * dt * e, &s, &c); pr = mag * c; pi = mag * s;
}

struct Args { const float* in[32]; float* out; unsigned char* ws; int ph_lo, ph_hi, li, pad; };

__global__ void __launch_bounds__(NWAVES * 64, 2) hymba_fwd(Args args) {
    extern __shared__ __attribute__((aligned(16))) unsigned char lds_raw[];
    LAS unsigned char* lds = (LAS unsigned char*)lds_raw;
    volatile LAS unsigned* MISC = (volatile LAS unsigned*)(lds + MISC_OFF);
    const int tid = threadIdx.x, lane = tid & 63, wave = __builtin_amdgcn_readfirstlane(tid >> 6);
    const int G = gridDim.x, bx = blockIdx.x;
    const int vcu = (G % 8 == 0) ? (bx % 8) * (G / 8) + bx / 8 : bx;
    unsigned char* ws = args.ws;
    unsigned* ctl = (unsigned*)(ws + WS_CTL);
    const float* x = args.in[0]; const float* pin = args.in[1];
    const float* ffn1_norm = args.in[2]; const float* ffn1_w1 = args.in[3]; const float* ffn1_w3 = args.in[4]; const float* ffn1_w2 = args.in[5];
    const float* mix_norm = args.in[6]; const float* w_in = args.in[7];
    const float* a_re = args.in[8]; const float* a_im = args.in[9]; const float* log_dt = args.in[10];
    const float* b_re = args.in[11]; const float* b_im = args.in[12]; const float* c_re = args.in[13]; const float* c_im = args.in[14];
    const float* d_skip = args.in[15]; const float* w_glu = args.in[16]; const float* b_glu = args.in[17];
    const float* w_pool = args.in[18]; const float* pool_scale = args.in[19];
    const float* ssm_out_norm = args.in[20]; const float* pool_out_norm = args.in[21]; const float* w_out = args.in[22];
    const float* ffn2_norm = args.in[23]; const float* ffn2_w1 = args.in[24]; const float* ffn2_w3 = args.in[25]; const float* ffn2_w2 = args.in[26];
    const float* ple_gate_norm = args.in[27]; const float* w_ple_gate = args.in[28]; const float* w_ple_proj = args.in[29];
    const float* ple_norm = args.in[30]; const float* final_norm = args.in[31];
    float* out = args.out;
    bf16* W13A = (bf16*)(ws + WS_W13A); bf16* W2A = (bf16*)(ws + WS_W2A); bf16* W13B = (bf16*)(ws + WS_W13B); bf16* W2B = (bf16*)(ws + WS_W2B);
    bf16* WIN = (bf16*)(ws + WS_WIN); bf16* WGLU = (bf16*)(ws + WS_WGLU); bf16* WO = (bf16*)(ws + WS_WO); bf16* WG = (bf16*)(ws + WS_WG); bf16* WPP = (bf16*)(ws + WS_WPP);
    bf16* S5BT = (bf16*)(ws + WS_S5BT); bf16* S5WE = (bf16*)(ws + WS_S5WE); float* A16 = (float*)(ws + WS_A16);
    float* SS0 = (float*)(ws + WS_SS0); float* SS1 = (float*)(ws + WS_SS1); float* SSS = (float*)(ws + WS_SSS); float* SS2 = (float*)(ws + WS_SS2);
    float* SS3 = (float*)(ws + WS_SS3); float* SSE = (float*)(ws + WS_SSE); float* SS4 = (float*)(ws + WS_SS4);
    bf16* HB = (bf16*)(ws + WS_HB); bf16* PB = (bf16*)(ws + WS_PB); bf16* EB = (bf16*)(ws + WS_E); bf16* A5 = (bf16*)(ws + WS_A5);
    bf16* ACT = (bf16*)(ws + WS_ACT); bf16* AEXT = (bf16*)(ws + WS_AEXT); bf16* QB = (bf16*)(ws + WS_Q); bf16* YACT = (bf16*)(ws + WS_YACT);

    for (int u = tid; u < (LDS_BYTES - LDSCTL_OFF) / 4; u += NWAVES * 64) ((LAS unsigned*)(lds + LDSCTL_OFF))[u] = 0u;
    __syncthreads();
    XcdBarrier bar; bar.bar = ctl + CW_BAR + args.li * XCD_BAR_WORDS; bar.x = 0; bar.st = nullptr;
    if (args.ph_hi - args.ph_lo > 1) bar = xcd_barrier_post(ctl + CW_BAR + args.li * XCD_BAR_WORDS, MISC + 8);
    const int lo = args.ph_lo, hi = args.ph_hi;
#ifndef PH_MASK
#define PH_MASK 0x7ff
#endif
#define IN(k) ((((PH_MASK) >> (k)) & 1) && lo <= (k) && (k) < hi)
#define SEAM(k) do { if (IN(k) && IN((k) + 1)) xcd_barrier(bar); } while (0)
    const int gw = vcu * NWAVES + wave, NGW = G * NWAVES;

    if (IN(0)) {
        LAS float* scr = (LAS float*)(lds + RING_OFF + wave * 16384);
        for (int it = gw; it < NG * 16; it += NGW) {
            const int g = it >> 4, j = it & 15, n = lane;
            const float dt = expf(log_dt[g]); const float lr = a_re[g * NS + n], li = a_im[g * NS + n];
            float abr, abi; cpow(lr, li, dt, 1.0f, abr, abi);
            const float den = lr * lr + li * li, nr = abr - 1.0f;
            const float f_r = (nr * lr + abi * li) / den, f_i = (abi * lr - nr * li) / den;
            float Bbr[16], Bbi[16];
            { const f32x4* brp = (const f32x4*)(b_re + (size_t)(g * NS + n) * 16); const f32x4* bip = (const f32x4*)(b_im + (size_t)(g * NS + n) * 16);
#pragma unroll
              for (int q4 = 0; q4 < 4; ++q4) { const f32x4 br = brp[q4], bi = bip[q4];
#pragma unroll
                  for (int e = 0; e < 4; ++e) { Bbr[4 * q4 + e] = f_r * br[e] - f_i * bi[e]; Bbi[4 * q4 + e] = f_r * bi[e] + f_i * br[e]; } } }
            float pjr, pji, p1r, p1i, p2r, p2i;
            cpow(lr, li, dt, (float)j, pjr, pji); cpow(lr, li, dt, (float)(j + 1), p1r, p1i); cpow(lr, li, dt, (float)(15 - j), p2r, p2i);
            if (j == 0) { float ar, ai; cpow(lr, li, dt, 16.0f, ar, ai); A16[(g * NS + n) * 2] = ar; A16[(g * NS + n) * 2 + 1] = ai; }
            { bf16* we = S5WE + (size_t)(g * 256) * 256 + j * 16;
              unsigned wr_[8], wi_[8];
#pragma unroll
              for (int q = 0; q < 16; q += 2) { const float r0 = p2r * Bbr[q] - p2i * Bbi[q], i0 = p2r * Bbi[q] + p2i * Bbr[q], r1 = p2r * Bbr[q + 1] - p2i * Bbi[q + 1], i1 = p2r * Bbi[q + 1] + p2i * Bbr[q + 1];
                  wr_[q >> 1] = cvt_pk_bf16(r0, r1); wi_[q >> 1] = cvt_pk_bf16(i0, i1); }
              *(v4u*)(we + (size_t)n * 256) = (v4u){wr_[0], wr_[1], wr_[2], wr_[3]}; *(v4u*)(we + (size_t)n * 256 + 8) = (v4u){wr_[4], wr_[5], wr_[6], wr_[7]};
              *(v4u*)(we + (size_t)(64 + n) * 256) = (v4u){wi_[0], wi_[1], wi_[2], wi_[3]}; *(v4u*)(we + (size_t)(64 + n) * 256 + 8) = (v4u){wi_[4], wi_[5], wi_[6], wi_[7]};
              bf16* z = S5WE + (size_t)(g * 256 + 128 + 8 * j) * 256 + lane * 32;
#pragma unroll
              for (int e = 0; e < 4; ++e) *(v4u*)(z + 8 * e) = (v4u){0u, 0u, 0u, 0u}; }
            LAS float* Wl = scr;
#pragma unroll
            for (int q4 = 0; q4 < 4; ++q4) { f32x4 wr4, wi4;
#pragma unroll
                for (int e = 0; e < 4; ++e) { const int q = 4 * q4 + e; wr4[e] = pjr * Bbr[q] - pji * Bbi[q]; wi4[e] = pjr * Bbi[q] + pji * Bbr[q]; }
                *(LAS f32x4*)(Wl + n * 32 + 4 * q4) = wr4; *(LAS f32x4*)(Wl + n * 32 + 16 + 4 * q4) = wi4; }
            bf16* btg = S5BT + (size_t)(g * 256) * 384;
#pragma unroll
            for (int p = 0; p < 16; ++p) {
                const float cr = c_re[(size_t)(g * 16 + p) * NS + n], ci = c_im[(size_t)(g * 16 + p) * NS + n];
                const float re = cr * p1r - ci * p1i, im = cr * p1i + ci * p1r; bf16* row = btg + (size_t)(j * 16 + p) * 384; row[n] = f2bf(re); row[64 + n] = f2bf(-im);
            }
            LDS_WAIT(); asm volatile("" ::: "memory");
            { const int p = lane >> 2, qq = 4 * (lane & 3);
              f32x4 a4 = (f32x4){0.f, 0.f, 0.f, 0.f};
              const f32x4* crp = (const f32x4*)(c_re + (size_t)(g * 16 + p) * NS); const f32x4* cip = (const f32x4*)(c_im + (size_t)(g * 16 + p) * NS);
#pragma unroll 1
              for (int nc = 0; nc < 4; ++nc) {
                  f32x4 cr4[4], ci4[4];
#pragma unroll
                  for (int i = 0; i < 4; ++i) { cr4[i] = crp[nc * 4 + i]; ci4[i] = cip[nc * 4 + i]; }
#pragma unroll
                  for (int i = 0; i < 4; ++i)
#pragma unroll
                      for (int e = 0; e < 4; ++e) { const int nn = nc * 16 + 4 * i + e;
                          const f32x4 wr4 = *(const LAS f32x4*)(Wl + nn * 32 + qq), wi4 = *(const LAS f32x4*)(Wl + nn * 32 + 16 + qq);
                          a4 += wr4 * cr4[i][e] - wi4 * ci4[i][e]; }
              }
              v2u val; val.x = cvt_pk_bf16(a4[0], a4[1]); val.y = cvt_pk_bf16(a4[2], a4[3]);
              for (int t = j; t < 16; ++t) *(v2u*)(btg + (size_t)(t * 16 + p) * 384 + 128 + (t - j) * 16 + qq) = val;
              if (j > 0) for (int t = 0; t < 16 - j; ++t) *(v2u*)(btg + (size_t)(t * 16 + p) * 384 + 128 + (t + j) * 16 + qq) = (v2u){0u, 0u};
            }
            LDS_WAIT(); asm volatile("" ::: "memory");
        }
        for (int it = gw - 512; it < (D / 8) * (SW / 64); it += NGW) {
            if (it < 0) continue;
            const int kb = it >> 3, db = it & 7, d = db * 64 + lane, gi = d >> 7, dd = d & 127, k0 = kb * 8;
            float a[8];
#pragma unroll
            for (int kk = 0; kk < 8; ++kk) a[kk] = 0.f;
            const float* wp = w_pool + (size_t)gi * 128 * 128 + dd;
            const float* wi = w_in + (size_t)k0 * D + 512 + gi * 128;
#pragma unroll 2
            for (int c = 0; c < 128; c += 4) {
                float wv[4];
#pragma unroll
                for (int e = 0; e < 4; ++e) wv[e] = wp[(size_t)(c + e) * 128];
#pragma unroll
                for (int kk = 0; kk < 8; ++kk) { const f32x4 w4 = *(const f32x4*)(wi + (size_t)kk * D + c); a[kk] += (w4[0] * wv[0] + w4[1] * wv[1]) + (w4[2] * wv[2] + w4[3] * wv[3]); }
            }
            const float ps = pool_scale[d];
            const f32x4 g0 = *(const f32x4*)(mix_norm + k0), g1 = *(const f32x4*)(mix_norm + k0 + 4);
            v4u o; o.x = cvt_pk_bf16(a[0] * ps * g0[0], a[1] * ps * g0[1]); o.y = cvt_pk_bf16(a[2] * ps * g0[2], a[3] * ps * g0[3]);
            o.z = cvt_pk_bf16(a[4] * ps * g1[0], a[5] * ps * g1[1]); o.w = cvt_pk_bf16(a[6] * ps * g1[2], a[7] * ps * g1[3]);
            *(v4u*)(WIN + (size_t)(512 + d) * D + k0) = o;
        }
        {
            constexpr int I_FF = (D / 64) * (FF / 32);
            constexpr int I_W2 = (FF / 64) * (D / 32);
            constexpr int I_SQ = (D / 64) * (D / 32);
            constexpr int I_IN = (D / 64) * (SW / 32);
            constexpr int I_GL = (SW / 64) * (SW / 32);
            constexpr int I_PP = (PLE / 64) * (D / 32);
            constexpr int NIT = 4 * I_FF + 2 * I_W2 + 2 * I_SQ + I_IN + I_GL + I_PP;
            for (int it = gw; it < NIT; it += NGW) {
                int r = it;
                if (r < 4 * I_FF) { const int which = r / I_FF; r -= which * I_FF; const int nb = FF / 32, kb = r / nb, n0 = (r % nb) * 32;
                    const float* W = which == 0 ? ffn1_w1 : which == 1 ? ffn1_w3 : which == 2 ? ffn2_w1 : ffn2_w3; bf16* WT = which < 2 ? W13A : W13B;
                    const int drow0 = (n0 >> 7) * 256 + (n0 & 127) + (which & 1) * 128;
                    transpose_item(W, D, FF, WT, kb * 64, n0, drow0, which < 2 ? ffn1_norm : ffn2_norm, 1.0f, scr, lane); continue; }
                r -= 4 * I_FF;
                if (r < 2 * I_W2) { const int which = r / I_W2; r -= which * I_W2; const int nb = D / 32, kb = r / nb, n0 = (r % nb) * 32;
                    transpose_item(which ? ffn2_w2 : ffn1_w2, FF, D, which ? W2B : W2A, kb * 64, n0, n0, nullptr, 0.5f, scr, lane); continue; }
                r -= 2 * I_W2;
                if (r < 2 * I_SQ) { const int which = r / I_SQ; r -= which * I_SQ; const int nb = D / 32, kb = r / nb, n0 = (r % nb) * 32;
                    if (which == 0) { const float* gn = (kb * 64 < SW) ? ssm_out_norm + kb * 64 : pool_out_norm + (kb * 64 - SW);
                        transpose_item(w_out, D, D, WO, kb * 64, n0, n0, gn - kb * 64, 1.0f, scr, lane); }
                    else transpose_item(w_ple_gate, D, D, WG, kb * 64, n0, n0, ple_gate_norm, 1.0f, scr, lane);
                    continue; }
                r -= 2 * I_SQ;
                if (r < I_IN) { const int nb = SW / 32, kb = r / nb, n0 = (r % nb) * 32; transpose_item(w_in, D, D, WIN, kb * 64, n0, n0, mix_norm, 1.0f, scr, lane); continue; }
                r -= I_IN;
                if (r < I_GL) { const int nb = SW / 32, kb = r / nb, n0 = (r % nb) * 32; transpose_item(w_glu, SW, SW, WGLU, kb * 64, n0, n0, nullptr, 1.0f, scr, lane); continue; }
                r -= I_GL;
                { const int nb = D / 32, kb = r / nb, n0 = (r % nb) * 32; transpose_item(w_ple_proj, PLE, D, WPP, kb * 64, n0, n0, nullptr, 1.0f, scr, lane); }
            }
        }
        for (int r0 = 2 * gw; r0 < M; r0 += 2 * NGW) {
            f32x4 v[2][4]; f32x4 pv[2]; float s[2];
#pragma unroll
            for (int h = 0; h < 2; ++h) { const f32x4* xr = (const f32x4*)(x + (size_t)(r0 + h) * D) + lane;
#pragma unroll
                for (int j = 0; j < 4; ++j) v[h][j] = xr[64 * j];
                pv[h] = *((const f32x4*)(pin + (size_t)(r0 + h) * PLE) + lane); }
#pragma unroll
            for (int h = 0; h < 2; ++h) { s[h] = 0.f;
#pragma unroll
                for (int j = 0; j < 4; ++j) s[h] += (v[h][j][0] * v[h][j][0] + v[h][j][1] * v[h][j][1]) + (v[h][j][2] * v[h][j][2] + v[h][j][3] * v[h][j][3]); }
            s[0] = wave_sum(s[0]); s[1] = wave_sum(s[1]);
            if (lane < 2) SS0[r0 + lane] = lane ? s[1] : s[0];
#pragma unroll
            for (int h = 0; h < 2; ++h) { v2u* o8 = (v2u*)(HB + (size_t)(r0 + h) * D) + lane;
#pragma unroll
                for (int j = 0; j < 4; ++j) { v2u w; w.x = cvt_pk_bf16(v[h][j][0], v[h][j][1]); w.y = cvt_pk_bf16(v[h][j][2], v[h][j][3]); o8[64 * j] = w; }
                v2u w; w.x = cvt_pk_bf16(pv[h][0], pv[h][1]); w.y = cvt_pk_bf16(pv[h][2], pv[h][3]); *((v2u*)(PB + (size_t)(r0 + h) * PLE) + lane) = w; }
        }
    }
    SEAM(0);

    if (IN(1)) {
        { pg8::Gemm g{PB, WPP, PLE, PLE, PLE}; pg8::StaticOrder S; S.init(M, D, G, bx); pg8::EpiEmb E{EB, SSE};
          pg8::gemm_phase<pg8::EpiEmb, pg8::StaticOrder, true>(lds + RING_OFF, g, S, E); }
        { pg8::Gemm g{HB, W13A, D, D, D}; pg8::StaticOrder S; S.init(M, NFF2, G, bx); pg8::EpiSwiGLU<1> E{ACT, FF, SS0, 1.0f / 1024.0f};
          pg8::gemm_phase<pg8::EpiSwiGLU<1>, pg8::StaticOrder, true>(lds + RING_OFF, g, S, E); }
    }
    SEAM(1);
    if (IN(2)) {
        pg8::Gemm g{ACT, W2A, FF, FF, FF}; pg8::StaticOrder S; S.init(M, D, G, bx); pg8::EpiResid<false> E{HB, SS1, nullptr, 0.f};
        pg8::gemm_phase<pg8::EpiResid<false>, pg8::StaticOrder, true>(lds + RING_OFF, g, S, E);
    }
    SEAM(2);
    if (IN(3)) {
        pg8::Gemm g{HB, WIN, D, D, D}; pg8::StaticOrder S; S.init(M, D, G, bx); pg8::EpiWin E{AEXT, QB, SS1};
        pg8::gemm_phase<pg8::EpiWin, pg8::StaticOrder, true>(lds + RING_OFF, g, S, E);
    }
    SEAM(3);
    if (IN(4)) {
        for (int unit = bx; unit < 256; unit += G) {
            const int g_ = unit >> 3;
            { pg8::Gemm g{AEXT + 128, S5WE, 384, 256, 256}; pg8::SingleUnit S{unit, g_}; pg8::EpiS5End E{};
              pg8::gemm_phase<pg8::EpiS5End, pg8::SingleUnit, false>(lds + RING_OFF, g, S, E); }
            LDS_WAIT(); __syncthreads();
            if (wave == 0) {
                const LAS float* El = (const LAS float*)(lds + RING_OFF);
                const float ar = A16[(g_ * NS + lane) * 2], ai = A16[(g_ * NS + lane) * 2 + 1];
                float cr = 0.f, ci = 0.f;
                bf16* dst = AEXT + (size_t)unit * 256 * 384 + lane;
#pragma unroll 1
                for (int c0 = 0; c0 < 256; c0 += 8) {
                    float er[8], ei[8];
#pragma unroll
                    for (int i = 0; i < 8; ++i) { er[i] = El[(c0 + i) * 128 + lane]; ei[i] = El[(c0 + i) * 128 + 64 + lane]; }
#pragma unroll
                    for (int i = 0; i < 8; ++i) {
                        dst[(size_t)(c0 + i) * 384] = f2bf(cr); dst[(size_t)(c0 + i) * 384 + 64] = f2bf(ci);
                        const float nr = ar * cr - ai * ci + er[i], ni = ar * ci + ai * cr + ei[i]; cr = nr; ci = ni;
                    }
                }
                __threadfence();
            }
            VM_WAIT(); __syncthreads();
            { pg8::Gemm g{AEXT, S5BT, 384, 384, 384}; pg8::SingleUnit S{unit, g_}; pg8::EpiS5Out E{AEXT, YACT, d_skip};
              pg8::gemm_phase<pg8::EpiS5Out, pg8::SingleUnit, false>(lds + RING_OFF, g, S, E); }
        }
        for (int blk = gw; blk < M / 16; blk += NGW) {
            const int w = 2 << (lane >> 4), r0 = blk * 16, l0 = r0 & (SEQ - 1);
            const bf16* qb = QB + (size_t)r0 * 512 + 8 * lane;
            float S[8];
#pragma unroll
            for (int e = 0; e < 8; ++e) S[e] = 0.f;
            if (l0 > 0) {
#pragma unroll
                for (int jj = 1; jj <= 16; ++jj) if (jj <= w) { const v4u qw = *(const v4u*)(qb - (ptrdiff_t)jj * 512);
                    S[0] += pg8::bf_lo(qw.x); S[1] += pg8::bf_hi(qw.x); S[2] += pg8::bf_lo(qw.y); S[3] += pg8::bf_hi(qw.y); S[4] += pg8::bf_lo(qw.z); S[5] += pg8::bf_hi(qw.z); S[6] += pg8::bf_lo(qw.w); S[7] += pg8::bf_hi(qw.w); }
            }
#pragma unroll
            for (int hh = 0; hh < 2; ++hh) {
                v4u cur[8], old[8];
#pragma unroll
                for (int i = 0; i < 8; ++i) { const int rr = hh * 8 + i; cur[i] = *(const v4u*)(qb + (size_t)rr * 512);
                    old[i] = (v4u){0u, 0u, 0u, 0u}; if (l0 + rr >= w) old[i] = *(const v4u*)(qb + ((ptrdiff_t)rr - w) * 512); }
                float pl[8][8], qs[8];
#pragma unroll
                for (int i = 0; i < 8; ++i) { const int rr = hh * 8 + i, l = l0 + rr; const int cnt = (l + 1) < w ? (l + 1) : w; const float ic = 1.0f / (float)cnt;
                    float f[8], o[8];
                    f[0] = pg8::bf_lo(cur[i].x); f[1] = pg8::bf_hi(cur[i].x); f[2] = pg8::bf_lo(cur[i].y); f[3] = pg8::bf_hi(cur[i].y); f[4] = pg8::bf_lo(cur[i].z); f[5] = pg8::bf_hi(cur[i].z); f[6] = pg8::bf_lo(cur[i].w); f[7] = pg8::bf_hi(cur[i].w);
                    o[0] = pg8::bf_lo(old[i].x); o[1] = pg8::bf_hi(old[i].x); o[2] = pg8::bf_lo(old[i].y); o[3] = pg8::bf_hi(old[i].y); o[4] = pg8::bf_lo(old[i].z); o[5] = pg8::bf_hi(old[i].z); o[6] = pg8::bf_lo(old[i].w); o[7] = pg8::bf_hi(old[i].w);
                    float q = 0.f;
#pragma unroll
                    for (int e = 0; e < 8; ++e) { S[e] += f[e] - o[e]; pl[i][e] = S[e] * ic - f[e]; q += pl[i][e] * pl[i][e]; }
                    qs[i] = q; }
#pragma unroll
                for (int i = 0; i < 8; ++i) qs[i] = wave_sum(qs[i]);
#pragma unroll
                for (int i = 0; i < 8; ++i) { const int rr = hh * 8 + i; const float rs = rsqrtf(qs[i] * (1.0f / 512.0f) + pg8::RMS_EPS);
                    v4u o; o.x = cvt_pk_bf16(pl[i][0] * rs, pl[i][1] * rs); o.y = cvt_pk_bf16(pl[i][2] * rs, pl[i][3] * rs); o.z = cvt_pk_bf16(pl[i][4] * rs, pl[i][5] * rs); o.w = cvt_pk_bf16(pl[i][6] * rs, pl[i][7] * rs);
                    *(v4u*)(A5 + (size_t)(r0 + rr) * 1024 + 512 + 8 * lane) = o; }
            }
        }
    }
    SEAM(4);
    if (IN(5)) {
        pg8::Gemm g{YACT, WGLU, SW, SW, SW}; pg8::StaticOrder S; S.init(M, SW, G, bx); pg8::EpiGlu E{YACT, A5, b_glu, SSS};
        pg8::gemm_phase<pg8::EpiGlu, pg8::StaticOrder, true>(lds + RING_OFF, g, S, E);
    }
    SEAM(5);
    if (IN(6)) {
        pg8::Gemm g{A5, WO, D, D, D}; pg8::StaticOrder S; S.init(M, D, G, bx); pg8::EpiResid<true> E{HB, SS2, SSS, 1.0f / 512.0f};
        pg8::gemm_phase<pg8::EpiResid<true>, pg8::StaticOrder, true>(lds + RING_OFF, g, S, E);
    }
    SEAM(6);
    if (IN(7)) {
        pg8::Gemm g{HB, W13B, D, D, D}; pg8::StaticOrder S; S.init(M, NFF2, G, bx); pg8::EpiSwiGLU<16> E{ACT, FF, SS2, 1.0f / 1024.0f};
        pg8::gemm_phase<pg8::EpiSwiGLU<16>, pg8::StaticOrder, true>(lds + RING_OFF, g, S, E);
    }
    SEAM(7);
    if (IN(8)) {
        pg8::Gemm g{ACT, W2B, FF, FF, FF}; pg8::StaticOrder S; S.init(M, D, G, bx); pg8::EpiResid<false> E{HB, SS3, nullptr, 0.f};
        pg8::gemm_phase<pg8::EpiResid<false>, pg8::StaticOrder, true>(lds + RING_OFF, g, S, E);
    }
    SEAM(8);
    if (IN(9)) {
        pg8::Gemm g{HB, WG, D, D, D}; pg8::StaticOrder S; S.init(M, D, G, bx); pg8::EpiGate E{out, HB, EB, SS3, SSE, ple_norm, SS4};
        pg8::gemm_phase<pg8::EpiGate, pg8::StaticOrder, true>(lds + RING_OFF, g, S, E);
    }
    SEAM(9);
    if (IN(10)) {
        for (int r = gw; r < M; r += NGW) {
            const float rs = pg8::row_rstd<16>(SS4, r, 1.0f / 1024.0f);
            f32x4* o = (f32x4*)(out + (size_t)r * D) + lane; const f32x4* gn = (const f32x4*)final_norm + lane;
#pragma unroll
            for (int j = 0; j < 4; ++j) { f32x4 v = o[64 * j]; const f32x4 gg = gn[64 * j]; v = v * rs * gg; o[64 * j] = v; }
        }
    }
#undef IN
#undef SEAM
}

extern "C" void kernel_launch(void* const* d_in, const int* in_sizes, int n_in, void* d_out, int out_size, void* d_ws, size_t ws_size, hipStream_t stream) {
    static int grid = 0;
    if (grid == 0) {
        if (n_in != 32 || in_sizes[0] != M * D || out_size != M * D || ws_size < WS_END) { fprintf(stderr, "kernel_launch: unexpected shapes (n_in %d, in0 %d, out %d, ws %zu)\n", n_in, n_in > 0 ? in_sizes[0] : -1, out_size, ws_size); grid = -1; return; }
        int dev = 0, cus = 0, per_cu = 0;
        if (hipGetDevice(&dev) != hipSuccess || hipDeviceGetAttribute(&cus, hipDeviceAttributeMultiprocessorCount, dev) != hipSuccess) { grid = -1; return; }
        if (hipFuncSetAttribute((const void*)hymba_fwd, hipFuncAttributeMaxDynamicSharedMemorySize, LDS_BYTES) != hipSuccess) { fprintf(stderr, "kernel_launch: hipFuncSetAttribute failed\n"); grid = -1; return; }
        if (hipOccupancyMaxActiveBlocksPerMultiprocessor(&per_cu, (const void*)hymba_fwd, NWAVES * 64, LDS_BYTES) != hipSuccess || per_cu < 1)
            fprintf(stderr, "kernel_launch: occupancy query reports %d workgroups per CU\n", per_cu);
        (void)hipGetLastError();
        grid = cus;
    }
    if (grid < 0) return;
    if (hipMemsetAsync((char*)d_ws + WS_CTL, 0, CTL_ZERO_BYTES, stream) != hipSuccess) { fprintf(stderr, "kernel_launch: memset failed\n"); return; }
    Args a{};
    for (int i = 0; i < 32; ++i) a.in[i] = (const float*)d_in[i];
    a.out = (float*)d_out; a.ws = (unsigned char*)d_ws;
#if defined(PROBE_PHASE)
    {
        const int k = PROBE_PHASE; const int los[3] = {0, k, k + 1}, his[3] = {k + 1, k + 1, NPHASE};
        for (int li = 0; li < 3; ++li) { if (los[li] >= his[li]) continue; a.ph_lo = los[li]; a.ph_hi = his[li]; a.li = li; hipLaunchKernelGGL(hymba_fwd, dim3(grid), dim3(NWAVES * 64), LDS_BYTES, stream, a); }
    }
#else
    if (N_LAUNCHES == 1) { a.ph_lo = 0; a.ph_hi = NPHASE; a.li = 0; hipLaunchKernelGGL(hymba_fwd, dim3(grid), dim3(NWAVES * 64), LDS_BYTES, stream, a); }
    else for (int li = 0; li < NPHASE; ++li) { a.ph_lo = li; a.ph_hi = li + 1; a.li = 0; hipLaunchKernelGGL(hymba_fwd, dim3(grid), dim3(NWAVES * 64), LDS_BYTES, stream, a); }
#endif
    const hipError_t le = hipPeekAtLastError();
    if (le != hipSuccess) fprintf(stderr, "kernel_launch: launch failed: %s\n", hipGetErrorName(le));
}
```

```cpp
#include <hip/hip_runtime.h>
#include <cstdio>
#include <cstdint>

#ifndef MK_N_LAUNCHES
#define MK_N_LAUNCHES 1
#endif

namespace pg8 {
#define PG8_LAS __attribute__((address_space(3)))
typedef unsigned short bf16_t;
typedef short bf16x8 __attribute__((ext_vector_type(8)));
typedef float f32x4 __attribute__((ext_vector_type(4)));
typedef float f32x2 __attribute__((ext_vector_type(2)));
typedef unsigned u32x4 __attribute__((ext_vector_type(4)));
typedef unsigned u32x2 __attribute__((ext_vector_type(2)));
constexpr int BM = 256, BK = 64, HALF = 128, HTB = HALF * BK * 2, STAGE_BYTES = 8 * HTB, NXCD = 8, WGM = 8;

__host__ __device__ __forceinline__ int lds_byte(int r, int c) { const int st = (r >> 4) * 2 + (c >> 5), rr = r & 15, cc = c & 31, ob = rr * 64 + cc * 2; return st * 1024 + (ob ^ (((ob >> 9) & 1) << 5)); }
__host__ __device__ __forceinline__ void stage_rc(int b, int& R, int& C) { const int st = b / 1024, sb = b % 1024, swz = sb ^ (((sb >> 9) & 1) << 5); R = (st >> 1) * 16 + swz / 64; C = (st & 1) * 32 + (swz % 64) / 2; }
__host__ __device__ __forceinline__ int perm32(int rho) { const int n = rho >> 4, i = rho & 15; return 8 * (i >> 2) + 4 * n + (i & 3); }

struct Unit { int pm, pn; };
struct Gemm { const bf16_t* A; const bf16_t* Bt; int lda, ldb, K; };

struct StaticOrder {
    int nM, nN, nwg, G, c;
    __device__ void init(int M, int N, int G_, int c_) { nM = M / BM; nN = N / BM; nwg = nM * nN; G = G_; c = c_; }
    __device__ bool next(int i, Unit& u) const {
        const long L = (long)i * G + c; if (L >= nwg) return false;
        int wgid = (int)L; { const int q = nwg / NXCD, r = nwg % NXCD, xcd = wgid % NXCD, off = wgid / NXCD; wgid = (xcd < r ? xcd * (q + 1) : r * (q + 1) + (xcd - r) * q) + off; }
        const int nig = WGM * nN, gid = wgid / nig, fm = gid * WGM, gsz = (nM - fm) < WGM ? (nM - fm) : WGM;
        u.pm = fm + ((wgid % nig) % gsz); u.pn = (wgid % nig) / gsz; return true;
    }
};
struct SingleUnit {
    int pm, pn;
    __device__ bool next(int i, Unit& u) const { if (i > 0) return false; u.pm = pm; u.pn = pn; return true; }
};

__device__ __forceinline__ unsigned cvt_pk_bf16(float lo, float hi) { unsigned r; asm volatile("v_cvt_pk_bf16_f32 %0, %1, %2" : "=v"(r) : "v"(lo), "v"(hi)); return r; }
__device__ __forceinline__ float bf_lo(unsigned w) { return __uint_as_float(w << 16); }
__device__ __forceinline__ float bf_hi(unsigned w) { return __uint_as_float(w & 0xffff0000u); }
__device__ __forceinline__ float sigm(float x) { return __builtin_amdgcn_rcpf(1.0f + __expf(-x)); }
constexpr float RMS_EPS = 1e-6f;
template <int NP> __device__ __forceinline__ float row_rstd(const float* ss, int r, float inv_n) {
    float s = 0.f;
    if constexpr (NP == 1) s = ss[r];
    else {
#pragma unroll
        for (int i = 0; i < NP / 4; ++i) { const f32x4 v = *(const f32x4*)(ss + (size_t)r * NP + 4 * i); s += (v[0] + v[1]) + (v[2] + v[3]); }
    }
    return rsqrtf(s * inv_n + RMS_EPS);
}
__device__ __forceinline__ float quad_sum(float q) { q += __shfl_xor(q, 16); q += __shfl_xor(q, 32); return q; }

#define EPI_ROW_LOOP _Pragma("unroll") for (int ai = 0; ai < 2; ++ai) _Pragma("unroll") for (int m = 0; m < 4; ++m)
#define EPI_ROW (u.pm * BM + ai * HALF + wr * 64 + m * 16 + fr)

template <int NP> struct EpiSwiGLU {
    static constexpr bool PERM = true, AFTER_DRAIN = false, MIDSCALE = false;
    bf16_t* O; int ldo; const float* ss; float inv_n;
    __device__ __forceinline__ void operator()(const f32x4 (&acc)[2][2][4][2], const Unit& u, int wr, int wc, int fr, int fq) const {
        const int col0 = u.pn * HALF + wc * 32 + 8 * fq;
        EPI_ROW_LOOP { const int r = EPI_ROW;
            const float rs = row_rstd<NP>(ss, r, inv_n);
            float o[8];
#pragma unroll
            for (int n = 0; n < 2; ++n)
#pragma unroll
                for (int j = 0; j < 4; ++j) { const float a = acc[ai][0][m][n][j] * rs, b = acc[ai][1][m][n][j] * rs; o[4 * n + j] = a * sigm(a) * b; }
            u32x4 w; w.x = cvt_pk_bf16(o[0], o[1]); w.y = cvt_pk_bf16(o[2], o[3]); w.z = cvt_pk_bf16(o[4], o[5]); w.w = cvt_pk_bf16(o[6], o[7]);
            *(u32x4*)(O + (size_t)r * ldo + col0) = w;
        }
    }
    __device__ __forceinline__ void midscale(f32x4 (&)[2][2][4][2], const Unit&, int, int) const {}
};

template <bool MID> struct EpiResid {
    static constexpr bool PERM = true, AFTER_DRAIN = false, MIDSCALE = MID;
    bf16_t* hb; float* ssout; const float* ssmid; float inv_mid;
    __device__ __forceinline__ void operator()(const f32x4 (&acc)[2][2][4][2], const Unit& u, int wr, int wc, int fr, int fq) const {
        const int colb = u.pn * BM + wc * 32 + 8 * fq;
        EPI_ROW_LOOP { const int r = EPI_ROW;
            float q = 0.f;
#pragma unroll
            for (int bj = 0; bj < 2; ++bj) {
                const size_t off = (size_t)r * 1024 + colb + bj * HALF;
                const u32x4 hw = *(const u32x4*)(hb + off);
                float v[8];
                v[0] = bf_lo(hw.x) + acc[ai][bj][m][0][0]; v[1] = bf_hi(hw.x) + acc[ai][bj][m][0][1]; v[2] = bf_lo(hw.y) + acc[ai][bj][m][0][2]; v[3] = bf_hi(hw.y) + acc[ai][bj][m][0][3];
                v[4] = bf_lo(hw.z) + acc[ai][bj][m][1][0]; v[5] = bf_hi(hw.z) + acc[ai][bj][m][1][1]; v[6] = bf_lo(hw.w) + acc[ai][bj][m][1][2]; v[7] = bf_hi(hw.w) + acc[ai][bj][m][1][3];
#pragma unroll
                for (int j = 0; j < 8; ++j) q += v[j] * v[j];
                u32x4 w; w.x = cvt_pk_bf16(v[0], v[1]); w.y = cvt_pk_bf16(v[2], v[3]); w.z = cvt_pk_bf16(v[4], v[5]); w.w = cvt_pk_bf16(v[6], v[7]);
                *(u32x4*)(hb + off) = w;
            }
            q = quad_sum(q);
            if (fq == 0) ssout[(size_t)r * 16 + u.pn * 4 + wc] = q;
        }
    }
    __device__ __forceinline__ void midscale(f32x4 (&acc)[2][2][4][2], const Unit& u, int wr, int fr) const {
        EPI_ROW_LOOP { const int r = EPI_ROW;
            const float rs = row_rstd<8>(ssmid, r, inv_mid);
#pragma unroll
            for (int bj = 0; bj < 2; ++bj)
#pragma unroll
                for (int n = 0; n < 2; ++n) acc[ai][bj][m][n] *= rs;
        }
    }
};

struct EpiWin {
    static constexpr bool PERM = true, AFTER_DRAIN = false, MIDSCALE = false;
    bf16_t* Aext; bf16_t* Q; const float* ss;
    __device__ __forceinline__ void operator()(const f32x4 (&acc)[2][2][4][2], const Unit& u, int wr, int wc, int fr, int fq) const {
        EPI_ROW_LOOP { const int r = EPI_ROW;
            const float rs = row_rstd<16>(ss, r, 1.0f / 1024.0f);
#pragma unroll
            for (int bj = 0; bj < 2; ++bj) {
                const f32x4 v0 = acc[ai][bj][m][0] * rs, v1 = acc[ai][bj][m][1] * rs;
                u32x4 w; w.x = cvt_pk_bf16(v0[0], v0[1]); w.y = cvt_pk_bf16(v0[2], v0[3]); w.z = cvt_pk_bf16(v1[0], v1[1]); w.w = cvt_pk_bf16(v1[2], v1[3]);
                const int c0 = (u.pn & 1) * BM + bj * HALF + wc * 32 + 8 * fq;
                if (u.pn < 2) { const int g = c0 >> 4, q0 = c0 & 15, b = r >> 12, l = r & 4095;
                    *(u32x4*)(Aext + ((size_t)((g * 8 + b) * 256 + (l >> 4))) * 384 + 128 + (l & 15) * 16 + q0) = w; }
                else *(u32x4*)(Q + (size_t)r * 512 + c0) = w;
            }
        }
    }
    __device__ __forceinline__ void midscale(f32x4 (&)[2][2][4][2], const Unit&, int, int) const {}
};

struct EpiGlu {
    static constexpr bool PERM = true, AFTER_DRAIN = false, MIDSCALE = false;
    const bf16_t* Y; bf16_t* A5; const float* bias; float* ssout;
    __device__ __forceinline__ void operator()(const f32x4 (&acc)[2][2][4][2], const Unit& u, int wr, int wc, int fr, int fq) const {
        const int colb = u.pn * BM + wc * 32 + 8 * fq;
        f32x4 bv[2][2];
#pragma unroll
        for (int bj = 0; bj < 2; ++bj)
#pragma unroll
            for (int n = 0; n < 2; ++n) bv[bj][n] = *(const f32x4*)(bias + colb + bj * HALF + 4 * n);
        EPI_ROW_LOOP { const int r = EPI_ROW;
            float q = 0.f;
#pragma unroll
            for (int bj = 0; bj < 2; ++bj) {
                const int c0 = colb + bj * HALF;
                const u32x4 yw = *(const u32x4*)(Y + (size_t)r * 512 + c0);
                const f32x4 g0 = acc[ai][bj][m][0] + bv[bj][0], g1 = acc[ai][bj][m][1] + bv[bj][1];
                float o[8];
                o[0] = bf_lo(yw.x) * sigm(g0[0]); o[1] = bf_hi(yw.x) * sigm(g0[1]); o[2] = bf_lo(yw.y) * sigm(g0[2]); o[3] = bf_hi(yw.y) * sigm(g0[3]);
                o[4] = bf_lo(yw.z) * sigm(g1[0]); o[5] = bf_hi(yw.z) * sigm(g1[1]); o[6] = bf_lo(yw.w) * sigm(g1[2]); o[7] = bf_hi(yw.w) * sigm(g1[3]);
#pragma unroll
                for (int j = 0; j < 8; ++j) q += o[j] * o[j];
                u32x4 w; w.x = cvt_pk_bf16(o[0], o[1]); w.y = cvt_pk_bf16(o[2], o[3]); w.z = cvt_pk_bf16(o[4], o[5]); w.w = cvt_pk_bf16(o[6], o[7]);
                *(u32x4*)(A5 + (size_t)r * 1024 + c0) = w;
            }
            q = quad_sum(q);
            if (fq == 0) ssout[(size_t)r * 8 + u.pn * 4 + wc] = q;
        }
    }
    __device__ __forceinline__ void midscale(f32x4 (&)[2][2][4][2], const Unit&, int, int) const {}
};

struct EpiEmb {
    static constexpr bool PERM = true, AFTER_DRAIN = false, MIDSCALE = false;
    bf16_t* E; float* ssout;
    __device__ __forceinline__ void operator()(const f32x4 (&acc)[2][2][4][2], const Unit& u, int wr, int wc, int fr, int fq) const {
        const int colb = u.pn * BM + wc * 32 + 8 * fq;
        EPI_ROW_LOOP { const int r = EPI_ROW;
            float q = 0.f;
#pragma unroll
            for (int bj = 0; bj < 2; ++bj) {
                const f32x4 v0 = acc[ai][bj][m][0], v1 = acc[ai][bj][m][1];
                q += (v0[0] * v0[0] + v0[1] * v0[1]) + (v0[2] * v0[2] + v0[3] * v0[3]) + (v1[0] * v1[0] + v1[1] * v1[1]) + (v1[2] * v1[2] + v1[3] * v1[3]);
                u32x4 w; w.x = cvt_pk_bf16(v0[0], v0[1]); w.y = cvt_pk_bf16(v0[2], v0[3]); w.z = cvt_pk_bf16(v1[0], v1[1]); w.w = cvt_pk_bf16(v1[2], v1[3]);
                *(u32x4*)(E + (size_t)r * 1024 + colb + bj * HALF) = w;
            }
            q = quad_sum(q);
            if (fq == 0) ssout[(size_t)r * 16 + u.pn * 4 + wc] = q;
        }
    }
    __device__ __forceinline__ void midscale(f32x4 (&)[2][2][4][2], const Unit&, int, int) const {}
};

struct EpiGate {
    static constexpr bool PERM = true, AFTER_DRAIN = false, MIDSCALE = false;
    float* out; const bf16_t* hb; const bf16_t* E; const float* ss3; const float* sse; const float* gple; float* ssout;
    __device__ __forceinline__ void operator()(const f32x4 (&acc)[2][2][4][2], const Unit& u, int wr, int wc, int fr, int fq) const {
        const int colb = u.pn * BM + wc * 32 + 8 * fq;
        EPI_ROW_LOOP { const int r = EPI_ROW;
            const float rs3 = row_rstd<16>(ss3, r, 1.0f / 1024.0f), rse = row_rstd<16>(sse, r, 1.0f / 1024.0f);
            float q = 0.f;
#pragma unroll
            for (int bj = 0; bj < 2; ++bj) {
                const int c0 = colb + bj * HALF; const size_t off = (size_t)r * 1024 + c0;
                const u32x4 ew = *(const u32x4*)(E + off);
                const f32x4 gp0 = *(const f32x4*)(gple + c0), gp1 = *(const f32x4*)(gple + c0 + 4);
                const u32x4 hw = *(const u32x4*)(hb + off);
                const f32x4 h0 = (f32x4){bf_lo(hw.x), bf_hi(hw.x), bf_lo(hw.y), bf_hi(hw.y)}, h1 = (f32x4){bf_lo(hw.z), bf_hi(hw.z), bf_lo(hw.w), bf_hi(hw.w)};
                const f32x4 a0 = acc[ai][bj][m][0] * rs3, a1 = acc[ai][bj][m][1] * rs3;
                f32x4 o0, o1;
                o0[0] = h0[0] + sigm(a0[0]) * (bf_lo(ew.x) * rse * gp0[0]); o0[1] = h0[1] + sigm(a0[1]) * (bf_hi(ew.x) * rse * gp0[1]);
                o0[2] = h0[2] + sigm(a0[2]) * (bf_lo(ew.y) * rse * gp0[2]); o0[3] = h0[3] + sigm(a0[3]) * (bf_hi(ew.y) * rse * gp0[3]);
                o1[0] = h1[0] + sigm(a1[0]) * (bf_lo(ew.z) * rse * gp1[0]); o1[1] = h1[1] + sigm(a1[1]) * (bf_hi(ew.z) * rse * gp1[1]);
                o1[2] = h1[2] + sigm(a1[2]) * (bf_lo(ew.w) * rse * gp1[2]); o1[3] = h1[3] + sigm(a1[3]) * (bf_hi(ew.w) * rse * gp1[3]);
                q += (o0[0] * o0[0] + o0[1] * o0[1]) + (o0[2] * o0[2] + o0[3] * o0[3]) + (o1[0] * o1[0] + o1[1] * o1[1]) + (o1[2] * o1[2] + o1[3] * o1[3]);
                *(f32x4*)(out + off) = o0; *(f32x4*)(out + off + 4) = o1;
            }
            q = quad_sum(q);
            if (fq == 0) ssout[(size_t)r * 16 + u.pn * 4 + wc] = q;
        }
    }
    __device__ __forceinline__ void midscale(f32x4 (&)[2][2][4][2], const Unit&, int, int) const {}
};

struct EpiS5End {
    static constexpr bool PERM = false, AFTER_DRAIN = true, MIDSCALE = false;
    __device__ __forceinline__ void fused(f32x4 (&acc)[2][2][4][2], const Unit&, int wr, int wc, int fr, int fq, PG8_LAS unsigned char* lds, int, int) const {
        PG8_LAS float* El = (PG8_LAS float*)lds;
#pragma unroll
        for (int ai = 0; ai < 2; ++ai)
#pragma unroll
            for (int m = 0; m < 4; ++m) { const int c = ai * HALF + wr * 64 + m * 16 + fr;
#pragma unroll
                for (int n = 0; n < 2; ++n) *(PG8_LAS f32x4*)(El + c * 128 + wc * 32 + n * 16 + 4 * fq) = acc[ai][0][m][n]; }
    }
    __device__ __forceinline__ void midscale(f32x4 (&)[2][2][4][2], const Unit&, int, int) const {}
};

struct EpiS5Out {
    static constexpr bool PERM = true, AFTER_DRAIN = false, MIDSCALE = false;
    const bf16_t* Aext; bf16_t* Y; const float* dskip;
    __device__ __forceinline__ void operator()(const f32x4 (&acc)[2][2][4][2], const Unit& u, int wr, int wc, int fr, int fq) const {
        const int g = u.pn, b = u.pm & 7;
        const int p0 = (8 * fq) & 15;
        const f32x4 d0 = *(const f32x4*)(dskip + g * 16 + p0), d1 = *(const f32x4*)(dskip + g * 16 + p0 + 4);
#pragma unroll
        for (int ai = 0; ai < 2; ++ai)
#pragma unroll
            for (int m = 0; m < 4; ++m) { const int c = ai * HALF + wr * 64 + m * 16 + fr;
#pragma unroll
                for (int bj = 0; bj < 2; ++bj) {
                    const int cl = bj * HALF + wc * 32 + 8 * fq, t = cl >> 4;
                    const u32x4 uw = *(const u32x4*)(Aext + ((size_t)u.pm * 256 + c) * 384 + 128 + cl);
                    float v[8];
                    v[0] = acc[ai][bj][m][0][0] + d0[0] * bf_lo(uw.x); v[1] = acc[ai][bj][m][0][1] + d0[1] * bf_hi(uw.x);
                    v[2] = acc[ai][bj][m][0][2] + d0[2] * bf_lo(uw.y); v[3] = acc[ai][bj][m][0][3] + d0[3] * bf_hi(uw.y);
                    v[4] = acc[ai][bj][m][1][0] + d1[0] * bf_lo(uw.z); v[5] = acc[ai][bj][m][1][1] + d1[1] * bf_hi(uw.z);
                    v[6] = acc[ai][bj][m][1][2] + d1[2] * bf_lo(uw.w); v[7] = acc[ai][bj][m][1][3] + d1[3] * bf_hi(uw.w);
#pragma unroll
                    for (int j = 0; j < 8; ++j) { const float x = v[j]; v[j] = x * sigm(1.5957691216f * (x + 0.044715f * x * x * x)); }
                    u32x4 w; w.x = cvt_pk_bf16(v[0], v[1]); w.y = cvt_pk_bf16(v[2], v[3]); w.z = cvt_pk_bf16(v[4], v[5]); w.w = cvt_pk_bf16(v[6], v[7]);
                    *(u32x4*)(Y + ((size_t)b * 4096 + c * 16 + t) * 512 + g * 16 + p0) = w;
                } }
    }
    __device__ __forceinline__ void midscale(f32x4 (&)[2][2][4][2], const Unit&, int, int) const {}
};

template <class Epi, class Sched, bool ALIGN_EPI = false, bool SP2 = true>
__device__ __forceinline__ void gemm_phase(PG8_LAS unsigned char* lds, const Gemm g, const Sched& S, const Epi& E) {
    const int tid = threadIdx.x, wid = __builtin_amdgcn_readfirstlane(tid >> 6), lane = tid & 63, wr = wid >> 2, wc = wid & 3, fr = lane & 15, fq = lane >> 4;
    int nt = g.K / BK; asm volatile("" : "+s"(nt));
    unsigned voffA[2], voffB[2];
#pragma unroll
    for (int i = 0; i < 2; ++i) { int R, C; stage_rc(tid * 16 + i * 8192, R, C); const int Rb = Epi::PERM ? ((R & ~31) + perm32(R & 31)) : R;
        voffA[i] = (unsigned)(R * g.lda + C) * 2u; voffB[i] = (unsigned)(Rb * g.ldb + C) * 2u; }
    const size_t kstep = (size_t)(BK * 2);
    const size_t hstepA = (size_t)HALF * g.lda * 2, hstepB = (size_t)HALF * g.ldb * 2;
    const size_t tstepA = 2 * hstepA, tstepB = 2 * hstepB;
    const unsigned ldsw = (unsigned)wid * 1024u;
    const int aoff = lds_byte(wr * 64 + fr, fq * 8), boff = lds_byte(wc * 32 + fr, fq * 8);
#define PG8_SA(b, h) (((b) * 2 + (h)) * HTB)
#define PG8_SB(b, h) ((4 + (b) * 2 + (h)) * HTB)
#define PG8_STAGE(bufoff, gbase, voff) do { _Pragma("unroll") for (int _i = 0; _i < 2; ++_i) \
        __builtin_amdgcn_global_load_lds((const unsigned*)((const char*)(gbase) + (voff)[_i]), (PG8_LAS unsigned*)(lds + (bufoff) + ldsw + _i * 8192), 16, 0, 0); } while (0)
#define PG8_LDA(dst, b, h) do { _Pragma("unroll") for (int m = 0; m < 4; ++m) _Pragma("unroll") for (int k = 0; k < 2; ++k) dst[m][k] = *(const PG8_LAS bf16x8*)(lds + PG8_SA(b, h) + aoff + m * 2048 + k * 1024); } while (0)
#define PG8_LDB(dst, b, h) do { _Pragma("unroll") for (int n = 0; n < 2; ++n) _Pragma("unroll") for (int k = 0; k < 2; ++k) dst[n][k] = *(const PG8_LAS bf16x8*)(lds + PG8_SB(b, h) + boff + n * 2048 + k * 1024); } while (0)
#define PG8_MMA(ai, bj, At, Bt) do { __builtin_amdgcn_s_setprio(1); _Pragma("unroll") for (int m = 0; m < 4; ++m) _Pragma("unroll") for (int n = 0; n < 2; ++n) _Pragma("unroll") for (int k = 0; k < 2; ++k) \
        acc[ai][bj][m][n] = __builtin_amdgcn_mfma_f32_16x16x32_bf16(Bt[n][k], At[m][k], acc[ai][bj][m][n], 0, 0, 0); __builtin_amdgcn_s_setprio(0); } while (0)
#define PG8_WAIT_V(n) asm volatile("s_waitcnt vmcnt(" #n ")" ::: "memory")
#define PG8_WAIT_L(n) asm volatile("s_waitcnt lgkmcnt(" #n ")" ::: "memory")
#define PG8_BAR __builtin_amdgcn_s_barrier()
#define PG8_SCHED __builtin_amdgcn_sched_barrier(0)
    Unit cur, nxt; int ui = 0;
    if (!S.next(0, cur)) return;
    f32x4 acc[2][2][4][2];
#pragma unroll
    for (int a = 0; a < 2; ++a)
#pragma unroll
        for (int b = 0; b < 2; ++b)
#pragma unroll
            for (int m = 0; m < 4; ++m)
#pragma unroll
                for (int n = 0; n < 2; ++n) acc[a][b][m][n] = (f32x4){0.f, 0.f, 0.f, 0.f};
    bf16x8 At[4][2], B0[2][2], B1[2][2];
    const char* cA = (const char*)g.A + (size_t)cur.pm * tstepA; const char* cB = (const char*)g.Bt + (size_t)cur.pn * tstepB;
    if constexpr (SP2) {
        PG8_STAGE(PG8_SB(0, 0), cB, voffB); PG8_STAGE(PG8_SB(0, 1), cB + hstepB, voffB); PG8_STAGE(PG8_SA(0, 0), cA, voffA); PG8_STAGE(PG8_SA(0, 1), cA + hstepA, voffA);
        if (wr == 1) PG8_BAR;
        PG8_WAIT_V(2); PG8_BAR;
        PG8_STAGE(PG8_SB(1, 0), cB + kstep, voffB); PG8_STAGE(PG8_SA(1, 0), cA + kstep, voffA); PG8_STAGE(PG8_SB(1, 1), cB + hstepB + kstep, voffB);
        PG8_WAIT_V(6); PG8_BAR;
    } else {
        PG8_STAGE(PG8_SB(0, 0), cB, voffB); PG8_STAGE(PG8_SA(0, 0), cA, voffA); PG8_STAGE(PG8_SB(0, 1), cB + hstepB, voffB); PG8_STAGE(PG8_SA(0, 1), cA + hstepA, voffA);
        if (wr == 1) PG8_BAR;
        PG8_WAIT_V(4); PG8_BAR;
        PG8_STAGE(PG8_SB(1, 0), cB + kstep, voffB); PG8_STAGE(PG8_SA(1, 0), cA + kstep, voffA); PG8_STAGE(PG8_SB(1, 1), cB + hstepB + kstep, voffB);
        PG8_WAIT_V(6); PG8_BAR;
    }
    for (;;) {
        const bool has_next = S.next(ui + 1, nxt);
        const char* nA = has_next ? (const char*)g.A + (size_t)nxt.pm * tstepA : cA; const char* nB = has_next ? (const char*)g.Bt + (size_t)nxt.pn * tstepB : cB;
        for (int t = 0; t < nt; t += 2) {
            const bool last = (t == nt - 2);
            const char* a1 = cA + (size_t)(t + 1) * kstep;
            const char* a2 = last ? nA : cA + (size_t)(t + 2) * kstep; const char* b2 = last ? nB : cB + (size_t)(t + 2) * kstep;
            const char* a3 = a2 + kstep; const char* b3 = b2 + kstep;
            if constexpr (Epi::MIDSCALE) { if (t == (nt >> 1)) E.midscale(acc, cur, wr, fr); }
            if constexpr (SP2) {
            PG8_LDB(B0, 0, 0); PG8_LDB(B1, 0, 1); PG8_SCHED; PG8_LDA(At, 0, 0); PG8_STAGE(PG8_SA(1, 1), a1 + hstepA, voffA);
            PG8_WAIT_V(8); PG8_WAIT_L(0); PG8_BAR; PG8_MMA(0, 0, At, B0); PG8_MMA(0, 1, At, B1); PG8_BAR; PG8_SCHED;
            PG8_LDA(At, 0, 1); PG8_STAGE(PG8_SB(0, 0), b2, voffB); PG8_STAGE(PG8_SB(0, 1), b2 + hstepB, voffB); PG8_STAGE(PG8_SA(0, 0), a2, voffA);
            PG8_WAIT_V(8); PG8_WAIT_L(0); PG8_BAR; PG8_MMA(1, 0, At, B0); PG8_MMA(1, 1, At, B1); PG8_BAR; PG8_SCHED;
            PG8_LDB(B0, 1, 0); PG8_LDB(B1, 1, 1); PG8_SCHED; PG8_LDA(At, 1, 0); PG8_STAGE(PG8_SA(0, 1), a2 + hstepA, voffA);
            PG8_WAIT_V(8); PG8_WAIT_L(0); PG8_BAR; PG8_MMA(0, 0, At, B0); PG8_MMA(0, 1, At, B1); PG8_BAR; PG8_SCHED;
            PG8_LDA(At, 1, 1); PG8_STAGE(PG8_SB(1, 0), b3, voffB); PG8_STAGE(PG8_SB(1, 1), b3 + hstepB, voffB); PG8_STAGE(PG8_SA(1, 0), a3, voffA);
            PG8_WAIT_V(8); PG8_WAIT_L(0); PG8_BAR; PG8_MMA(1, 0, At, B0); PG8_MMA(1, 1, At, B1); PG8_BAR; PG8_SCHED;
            } else {
            PG8_LDB(B0, 0, 0); PG8_SCHED; PG8_LDA(At, 0, 0); PG8_STAGE(PG8_SA(1, 1), a1 + hstepA, voffA);
            PG8_WAIT_L(8); PG8_BAR; PG8_WAIT_L(0); PG8_MMA(0, 0, At, B0); PG8_BAR; PG8_SCHED;
            PG8_LDB(B1, 0, 1); PG8_STAGE(PG8_SB(0, 0), b2, voffB);
            PG8_BAR; PG8_WAIT_L(0); PG8_MMA(0, 1, At, B1); PG8_BAR;
            PG8_LDA(At, 0, 1); PG8_STAGE(PG8_SA(0, 0), a2, voffA);
            PG8_BAR; PG8_WAIT_L(0); PG8_MMA(1, 0, At, B0); PG8_BAR; PG8_SCHED;
            PG8_STAGE(PG8_SB(0, 1), b2 + hstepB, voffB);
            PG8_WAIT_V(6); PG8_BAR; PG8_MMA(1, 1, At, B1); PG8_BAR;
            PG8_LDB(B0, 1, 0); PG8_SCHED; PG8_LDA(At, 1, 0); PG8_STAGE(PG8_SA(0, 1), a2 + hstepA, voffA);
            PG8_WAIT_L(8); PG8_BAR; PG8_WAIT_L(0); PG8_MMA(0, 0, At, B0); PG8_BAR; PG8_SCHED;
            PG8_LDB(B1, 1, 1); PG8_STAGE(PG8_SB(1, 0), b3, voffB);
            PG8_BAR; PG8_WAIT_L(0); PG8_MMA(0, 1, At, B1); PG8_BAR;
            PG8_LDA(At, 1, 1); PG8_STAGE(PG8_SA(1, 0), a3, voffA);
            PG8_BAR; PG8_WAIT_L(0); PG8_MMA(1, 0, At, B0); PG8_BAR; PG8_SCHED;
            PG8_STAGE(PG8_SB(1, 1), b3 + hstepB, voffB);
            PG8_WAIT_V(6); PG8_BAR; PG8_MMA(1, 1, At, B1); PG8_BAR;
            }
        }
        if constexpr (ALIGN_EPI) { if (wr == 0) PG8_BAR; }
        if constexpr (!Epi::AFTER_DRAIN) { E(acc, cur, wr, wc, fr, fq); }
        if (!has_next) break;
#pragma unroll
        for (int a = 0; a < 2; ++a)
#pragma unroll
            for (int b = 0; b < 2; ++b)
#pragma unroll
                for (int m = 0; m < 4; ++m)
#pragma unroll
                    for (int n = 0; n < 2; ++n) acc[a][b][m][n] = (f32x4){0.f, 0.f, 0.f, 0.f};
        cur = nxt; cA = nA; cB = nB; ++ui;
        if constexpr (ALIGN_EPI) { if (wr == 1) PG8_BAR; }
    }
    PG8_WAIT_V(0);
    if constexpr (!ALIGN_EPI) { if (wr == 0) PG8_BAR; }
    PG8_BAR;
    if constexpr (Epi::AFTER_DRAIN) { E.fused(acc, cur, wr, wc, fr, fq, lds, wid, lane); }
#undef PG8_SA
#undef PG8_SB
#undef PG8_STAGE
#undef PG8_LDA
#undef PG8_LDB
#undef PG8_MMA
#undef PG8_WAIT_V
#undef PG8_WAIT_L
#undef PG8_BAR
#undef PG8_SCHED
}
}

constexpr int NWAVES = 8;
constexpr int N_LAUNCHES = MK_N_LAUNCHES;
constexpr int NPHASE = 11;
constexpr int M = 32768, D = 1024, FF = 2816, NFF2 = 2 * FF, SW = 512, PLE = 256, SEQ = 4096;
constexpr int NG = 32, NS = 64, GP = 16;
constexpr size_t MiB = 1u << 20;
constexpr size_t WS_CTL = 0, CTL_ZERO_BYTES = 1 * MiB;
constexpr size_t WS_W13A = 2 * MiB, WS_W2A = 13 * MiB, WS_W13B = 19 * MiB, WS_W2B = 30 * MiB;
constexpr size_t WS_WIN = 36 * MiB, WS_WGLU = 38 * MiB, WS_WO = 39 * MiB, WS_WG = 41 * MiB, WS_WPP = 43 * MiB;
constexpr size_t WS_S5BT = 44 * MiB, WS_S5WE = 50 * MiB, WS_A16 = 54 * MiB;
constexpr size_t WS_SS0 = 56 * MiB, WS_SS1 = 58 * MiB, WS_SSS = 60 * MiB, WS_SS2 = 62 * MiB, WS_SS3 = 64 * MiB, WS_SSE = 66 * MiB, WS_SS4 = 68 * MiB;
constexpr size_t WS_HB = 72 * MiB, WS_PB = 136 * MiB, WS_E = 152 * MiB, WS_A5 = 216 * MiB, WS_ACT = 280 * MiB;
constexpr size_t WS_AEXT = WS_ACT, WS_Q = 328 * MiB, WS_YACT = 360 * MiB, WS_END = 456 * MiB;
static_assert(WS_W13A + (size_t)NFF2 * D * 2 <= WS_W2A && WS_W2A + (size_t)D * FF * 2 <= WS_W13B && WS_W13B + (size_t)NFF2 * D * 2 <= WS_W2B && WS_W2B + (size_t)D * FF * 2 <= WS_WIN, "ws map 1");
static_assert(WS_S5BT + (size_t)NG * 256 * 384 * 2 <= WS_S5WE && WS_S5WE + (size_t)NG * 256 * 256 * 2 <= WS_A16, "ws map 2");
static_assert(WS_ACT + (size_t)M * FF * 2 <= WS_END && WS_AEXT + (size_t)256 * 256 * 384 * 2 <= WS_Q && WS_Q + (size_t)M * 512 * 2 <= WS_YACT && WS_YACT + (size_t)M * 512 * 2 <= WS_END, "ws map 3");
constexpr int CW_BAR = 4096;
constexpr int RING_OFF = 0, RING_BYTES = 131072, LDSCTL_OFF = RING_BYTES, MISC_OFF = LDSCTL_OFF + 320, LDS_BYTES = 147456;

#define LAS __attribute__((address_space(3)))
typedef unsigned short bf16;
typedef unsigned v4u __attribute__((ext_vector_type(4)));
typedef unsigned v2u __attribute__((ext_vector_type(2)));
typedef float f32x4 __attribute__((ext_vector_type(4)));
#define LDS_WAIT() asm volatile("s_waitcnt lgkmcnt(0)" ::: "memory")
#define VM_WAIT() asm volatile("s_waitcnt vmcnt(0)" ::: "memory")
using pg8::cvt_pk_bf16;
__device__ __forceinline__ unsigned short f2bf(float f) { return (unsigned short)(cvt_pk_bf16(f, 0.f) & 0xffffu); }

#define XB_TMO      128
#define XB_XCNT(j)  (256  + 64 * (j))
#define XB_XSUB(j)  (1280 + 64 * (j))
#define XB_XGEN(j)  (2304 + 64 * (j))
#define XB_TOP      3328
#define XB_TOPGEN   3392
#define XCD_BAR_WORDS 3456
#define XB_SPIN_CAP (1u << 20)
__device__ __forceinline__ unsigned xb_ld(unsigned* p)              { return __hip_atomic_load(p, __ATOMIC_RELAXED, __HIP_MEMORY_SCOPE_AGENT); }
__device__ __forceinline__ unsigned xb_add(unsigned* p, unsigned v) { return __hip_atomic_fetch_add(p, v, __ATOMIC_RELAXED, __HIP_MEMORY_SCOPE_AGENT); }
__device__ __forceinline__ unsigned xb_xcc_id() { return (unsigned)__builtin_amdgcn_s_getreg((3 << 11) | 20) & 0xFu; }
#define XB_SPIN(cond, bar) do { unsigned _sp = 0; while (cond) { __builtin_amdgcn_s_sleep(1); \
    if ((++_sp & 255u) == 0u) { if (xb_ld(&(bar)[XB_TMO])) break; if (_sp > XB_SPIN_CAP) { atomicAdd(&(bar)[XB_TMO], 1u); break; } } } } while (0)
struct XcdBarrier { unsigned* bar; unsigned x; volatile LAS unsigned* st; };
__device__ __forceinline__ XcdBarrier xcd_barrier_post(unsigned* bar, volatile LAS unsigned* st) {
    XcdBarrier b; b.bar = bar; b.x = xb_xcc_id(); b.st = st;
    if (threadIdx.x == 0) (void)xb_add(&bar[XB_XCNT(b.x)], 1u);
    return b;
}
__device__ __forceinline__ void xcd_barrier_complete(unsigned* bar, unsigned x, unsigned& nloc, unsigned& nx) {
    const unsigned G = gridDim.x * gridDim.y * gridDim.z;
    unsigned sum, cnt, mine, sp = 0u;
    for (;;) {
        sum = 0u; cnt = 0u; mine = 0u;
#pragma unroll
        for (unsigned j = 0; j < 16; ++j) { const unsigned c = xb_ld(&bar[XB_XCNT(j)]); sum += c; cnt += (c > 0u) ? 1u : 0u; mine = (j == x) ? c : mine; }
        if (sum == G) break;
        __builtin_amdgcn_s_sleep(1);
        if ((++sp & 255u) == 0u) { if (xb_ld(&bar[XB_TMO])) break; if (sp > XB_SPIN_CAP) { atomicAdd(&bar[XB_TMO], 1u); break; } }
    }
    nloc = mine > 0u ? mine : 1u; nx = cnt > 0u ? cnt : 1u;
}
__device__ __forceinline__ void xcd_barrier(const XcdBarrier& b) {
    asm volatile("s_waitcnt vmcnt(0)" ::: "memory");
    __syncthreads();
    if (threadIdx.x == 0) {
        unsigned* bar = b.bar;
        __builtin_amdgcn_s_waitcnt(0);
        unsigned nloc = b.st[0], nx = b.st[1];
        if (nloc == 0u) { xcd_barrier_complete(bar, b.x, nloc, nx); b.st[0] = nloc; b.st[1] = nx; }
        const unsigned old = xb_add(&bar[XB_XSUB(b.x)], 1u);
        const unsigned gen = old / nloc;
        if (old + 1u == (gen + 1u) * nloc) {
            __builtin_amdgcn_fence(__ATOMIC_RELEASE, "agent");
            asm volatile("s_waitcnt vmcnt(0)" ::: "memory");
            const unsigned og = xb_add(&bar[XB_TOP], 1u);
            const unsigned tg = og / nx;
            if (og + 1u == (tg + 1u) * nx) xb_add(&bar[XB_TOPGEN], 1u);
            else XB_SPIN(xb_ld(&bar[XB_TOPGEN]) == tg, bar);
            __builtin_amdgcn_fence(__ATOMIC_ACQUIRE, "agent");
            xb_add(&bar[XB_XGEN(b.x)], 1u);
            asm volatile("s_waitcnt vmcnt(0)" ::: "memory");
        } else {
            XB_SPIN(xb_ld(&bar[XB_XGEN(b.x)]) == gen, bar);
            __builtin_amdgcn_fence(__ATOMIC_ACQUIRE, "agent");
            asm volatile("s_waitcnt vmcnt(0)" ::: "memory");
        }
    }
    __syncthreads();
}

__device__ __forceinline__ float wave_sum(float v) {
#pragma unroll
    for (int o = 1; o < 64; o <<= 1) v += __shfl_xor(v, o);
    return v;
}
__device__ __forceinline__ void transpose_item(const float* W, int K, int N, bf16* WT, int k0, int n0, int drow0, const float* gain, float scale, LAS float* scr, int lane) {
    f32x4 v[8]; float gk[8];
    const int rr = lane >> 3, c4 = 4 * (lane & 7);
#pragma unroll
    for (int i = 0; i < 8; ++i) { const int kk = i * 8 + rr; v[i] = *(const f32x4*)(W + (size_t)(k0 + kk) * N + n0 + c4); gk[i] = gain ? gain[k0 + kk] * scale : scale; }
#pragma unroll
    for (int i = 0; i < 8; ++i) { const int kk = i * 8 + rr; LAS float* d = scr + kk * 33 + c4; d[0] = v[i][0] * gk[i]; d[1] = v[i][1] * gk[i]; d[2] = v[i][2] * gk[i]; d[3] = v[i][3] * gk[i]; }
    LDS_WAIT(); asm volatile("" ::: "memory");
    const int c = lane & 7;
#pragma unroll
    for (int j = 0; j < 4; ++j) { const int n = (lane >> 3) + 8 * j; const LAS float* s = scr + (8 * c) * 33 + n;
        v4u o; o.x = cvt_pk_bf16(s[0 * 33], s[1 * 33]); o.y = cvt_pk_bf16(s[2 * 33], s[3 * 33]); o.z = cvt_pk_bf16(s[4 * 33], s[5 * 33]); o.w = cvt_pk_bf16(s[6 * 33], s[7 * 33]);
        *(v4u*)(WT + (size_t)(drow0 + n) * K + k0 + 8 * c) = o; }
    LDS_WAIT(); asm volatile("" ::: "memory");
}
__device__ __forceinline__ void cpow(float lr, float li, float dt, float e, float& pr, float& pi) {
    const float mag = expf(lr * dt * e); float s, c; sincosf(li * dt * e, &s, &c); pr = mag * c; pi = mag * s;
}

struct Args { const float* in[32]; float* out; unsigned char* ws; int ph_lo, ph_hi, li, pad; };

__global__ void __launch_bounds__(NWAVES * 64, 2) hymba_fwd(Args args) {
    extern __shared__ __attribute__((aligned(16))) unsigned char lds_raw[];
    LAS unsigned char* lds = (LAS unsigned char*)lds_raw;
    volatile LAS unsigned* MISC = (volatile LAS unsigned*)(lds + MISC_OFF);
    const int tid = threadIdx.x, lane = tid & 63, wave = __builtin_amdgcn_readfirstlane(tid >> 6);
    const int G = gridDim.x, bx = blockIdx.x;
    const int vcu = (G % 8 == 0) ? (bx % 8) * (G / 8) + bx / 8 : bx;
    unsigned char* ws = args.ws;
    unsigned* ctl = (unsigned*)(ws + WS_CTL);
    const float* x = args.in[0]; const float* pin = args.in[1];
    const float* ffn1_norm = args.in[2]; const float* ffn1_w1 = args.in[3]; const float* ffn1_w3 = args.in[4]; const float* ffn1_w2 = args.in[5];
    const float* mix_norm = args.in[6]; const float* w_in = args.in[7];
    const float* a_re = args.in[8]; const float* a_im = args.in[9]; const float* log_dt = args.in[10];
    const float* b_re = args.in[11]; const float* b_im = args.in[12]; const float* c_re = args.in[13]; const float* c_im = args.in[14];
    const float* d_skip = args.in[15]; const float* w_glu = args.in[16]; const float* b_glu = args.in[17];
    const float* w_pool = args.in[18]; const float* pool_scale = args.in[19];
    const float* ssm_out_norm = args.in[20]; const float* pool_out_norm = args.in[21]; const float* w_out = args.in[22];
    const float* ffn2_norm = args.in[23]; const float* ffn2_w1 = args.in[24]; const float* ffn2_w3 = args.in[25]; const float* ffn2_w2 = args.in[26];
    const float* ple_gate_norm = args.in[27]; const float* w_ple_gate = args.in[28]; const float* w_ple_proj = args.in[29];
    const float* ple_norm = args.in[30]; const float* final_norm = args.in[31];
    float* out = args.out;
    bf16* W13A = (bf16*)(ws + WS_W13A); bf16* W2A = (bf16*)(ws + WS_W2A); bf16* W13B = (bf16*)(ws + WS_W13B); bf16* W2B = (bf16*)(ws + WS_W2B);
    bf16* WIN = (bf16*)(ws + WS_WIN); bf16* WGLU = (bf16*)(ws + WS_WGLU); bf16* WO = (bf16*)(ws + WS_WO); bf16* WG = (bf16*)(ws + WS_WG); bf16* WPP = (bf16*)(ws + WS_WPP);
    bf16* S5BT = (bf16*)(ws + WS_S5BT); bf16* S5WE = (bf16*)(ws + WS_S5WE); float* A16 = (float*)(ws + WS_A16);
    float* SS0 = (float*)(ws + WS_SS0); float* SS1 = (float*)(ws + WS_SS1); float* SSS = (float*)(ws + WS_SSS); float* SS2 = (float*)(ws + WS_SS2);
    float* SS3 = (float*)(ws + WS_SS3); float* SSE = (float*)(ws + WS_SSE); float* SS4 = (float*)(ws + WS_SS4);
    bf16* HB = (bf16*)(ws + WS_HB); bf16* PB = (bf16*)(ws + WS_PB); bf16* EB = (bf16*)(ws + WS_E); bf16* A5 = (bf16*)(ws + WS_A5);
    bf16* ACT = (bf16*)(ws + WS_ACT); bf16* AEXT = (bf16*)(ws + WS_AEXT); bf16* QB = (bf16*)(ws + WS_Q); bf16* YACT = (bf16*)(ws + WS_YACT);

    for (int u = tid; u < (LDS_BYTES - LDSCTL_OFF) / 4; u += NWAVES * 64) ((LAS unsigned*)(lds + LDSCTL_OFF))[u] = 0u;
    __syncthreads();
    XcdBarrier bar; bar.bar = ctl + CW_BAR + args.li * XCD_BAR_WORDS; bar.x = 0; bar.st = nullptr;
    if (args.ph_hi - args.ph_lo > 1) bar = xcd_barrier_post(ctl + CW_BAR + args.li * XCD_BAR_WORDS, MISC + 8);
    const int lo = args.ph_lo, hi = args.ph_hi;
#ifndef PH_MASK
#define PH_MASK 0x7ff
#endif
#define IN(k) ((((PH_MASK) >> (k)) & 1) && lo <= (k) && (k) < hi)
#define SEAM(k) do { if (IN(k) && IN((k) + 1)) xcd_barrier(bar); } while (0)
    const int gw = vcu * NWAVES + wave, NGW = G * NWAVES;

    if (IN(0)) {
        LAS float* scr = (LAS float*)(lds + RING_OFF + wave * 16384);
        for (int it = gw; it < NG * 16; it += NGW) {
            const int g = it >> 4, j = it & 15, n = lane;
            const float dt = expf(log_dt[g]); const float lr = a_re[g * NS + n], li = a_im[g * NS + n];
            float abr, abi; cpow(lr, li, dt, 1.0f, abr, abi);
            const float den = lr * lr + li * li, nr = abr - 1.0f;
            const float f_r = (nr * lr + abi * li) / den, f_i = (abi * lr - nr * li) / den;
            float Bbr[16], Bbi[16];
            { const f32x4* brp = (const f32x4*)(b_re + (size_t)(g * NS + n) * 16); const f32x4* bip = (const f32x4*)(b_im + (size_t)(g * NS + n) * 16);
#pragma unroll
              for (int q4 = 0; q4 < 4; ++q4) { const f32x4 br = brp[q4], bi = bip[q4];
#pragma unroll
                  for (int e = 0; e < 4; ++e) { Bbr[4 * q4 + e] = f_r * br[e] - f_i * bi[e]; Bbi[4 * q4 + e] = f_r * bi[e] + f_i * br[e]; } } }
            float pjr, pji, p1r, p1i, p2r, p2i;
            cpow(lr, li, dt, (float)j, pjr, pji); cpow(lr, li, dt, (float)(j + 1), p1r, p1i); cpow(lr, li, dt, (float)(15 - j), p2r, p2i);
            if (j == 0) { float ar, ai; cpow(lr, li, dt, 16.0f, ar, ai); A16[(g * NS + n) * 2] = ar; A16[(g * NS + n) * 2 + 1] = ai; }
            { bf16* we = S5WE + (size_t)(g * 256) * 256 + j * 16;
              unsigned wr_[8], wi_[8];
#pragma unroll
              for (int q = 0; q < 16; q += 2) { const float r0 = p2r * Bbr[q] - p2i * Bbi[q], i0 = p2r * Bbi[q] + p2i * Bbr[q], r1 = p2r * Bbr[q + 1] - p2i * Bbi[q + 1], i1 = p2r * Bbi[q + 1] + p2i * Bbr[q + 1];
                  wr_[q >> 1] = cvt_pk_bf16(r0, r1); wi_[q >> 1] = cvt_pk_bf16(i0, i1); }
              *(v4u*)(we + (size_t)n * 256) = (v4u){wr_[0], wr_[1], wr_[2], wr_[3]}; *(v4u*)(we + (size_t)n * 256 + 8) = (v4u){wr_[4], wr_[5], wr_[6], wr_[7]};
              *(v4u*)(we + (size_t)(64 + n) * 256) = (v4u){wi_[0], wi_[1], wi_[2], wi_[3]}; *(v4u*)(we + (size_t)(64 + n) * 256 + 8) = (v4u){wi_[4], wi_[5], wi_[6], wi_[7]};
              bf16* z = S5WE + (size_t)(g * 256 + 128 + 8 * j) * 256 + lane * 32;
#pragma unroll
              for (int e = 0; e < 4; ++e) *(v4u*)(z + 8 * e) = (v4u){0u, 0u, 0u, 0u}; }
            LAS float* Wl = scr;
#pragma unroll
            for (int q4 = 0; q4 < 4; ++q4) { f32x4 wr4, wi4;
#pragma unroll
                for (int e = 0; e < 4; ++e) { const int q = 4 * q4 + e; wr4[e] = pjr * Bbr[q] - pji * Bbi[q]; wi4[e] = pjr * Bbi[q] + pji * Bbr[q]; }
                *(LAS f32x4*)(Wl + n * 32 + 4 * q4) = wr4; *(LAS f32x4*)(Wl + n * 32 + 16 + 4 * q4) = wi4; }
            bf16* btg = S5BT + (size_t)(g * 256) * 384;
#pragma unroll
            for (int p = 0; p < 16; ++p) {
                const float cr = c_re[(size_t)(g * 16 + p) * NS + n], ci = c_im[(size_t)(g * 16 + p) * NS + n];
                const float re = cr * p1r - ci * p1i, im = cr * p1i + ci * p1r; bf16* row = btg + (size_t)(j * 16 + p) * 384; row[n] = f2bf(re); row[64 + n] = f2bf(-im);
            }
            LDS_WAIT(); asm volatile("" ::: "memory");
            { const int p = lane >> 2, qq = 4 * (lane & 3);
              f32x4 a4 = (f32x4){0.f, 0.f, 0.f, 0.f};
              const f32x4* crp = (const f32x4*)(c_re + (size_t)(g * 16 + p) * NS); const f32x4* cip = (const f32x4*)(c_im + (size_t)(g * 16 + p) * NS);
#pragma unroll 1
              for (int nc = 0; nc < 4; ++nc) {
                  f32x4 cr4[4], ci4[4];
#pragma unroll
                  for (int i = 0; i < 4; ++i) { cr4[i] = crp[nc * 4 + i]; ci4[i] = cip[nc * 4 + i]; }
#pragma unroll
                  for (int i = 0; i < 4; ++i)
#pragma unroll
                      for (int e = 0; e < 4; ++e) { const int nn = nc * 16 + 4 * i + e;
                          const f32x4 wr4 = *(const LAS f32x4*)(Wl + nn * 32 + qq), wi4 = *(const LAS f32x4*)(Wl + nn * 32 + 16 + qq);
                          a4 += wr4 * cr4[i][e] - wi4 * ci4[i][e]; }
              }
              v2u val; val.x = cvt_pk_bf16(a4[0], a4[1]); val.y = cvt_pk_bf16(a4[2], a4[3]);
              for (int t = j; t < 16; ++t) *(v2u*)(btg + (size_t)(t * 16 + p) * 384 + 128 + (t - j) * 16 + qq) = val;
              if (j > 0) for (int t = 0; t < 16 - j; ++t) *(v2u*)(btg + (size_t)(t * 16 + p) * 384 + 128 + (t + j) * 16 + qq) = (v2u){0u, 0u};
            }
            LDS_WAIT(); asm volatile("" ::: "memory");
        }
        for (int it = gw - 512; it < (D / 8) * (SW / 64); it += NGW) {
            if (it < 0) continue;
            const int kb = it >> 3, db = it & 7, d = db * 64 + lane, gi = d >> 7, dd = d & 127, k0 = kb * 8;
            float a[8];
#pragma unroll
            for (int kk = 0; kk < 8; ++kk) a[kk] = 0.f;
            const float* wp = w_pool + (size_t)gi * 128 * 128 + dd;
            const float* wi = w_in + (size_t)k0 * D + 512 + gi * 128;
#pragma unroll 2
            for (int c = 0; c < 128; c += 4) {
                float wv[4];
#pragma unroll
                for (int e = 0; e < 4; ++e) wv[e] = wp[(size_t)(c + e) * 128];
#pragma unroll
                for (int kk = 0; kk < 8; ++kk) { const f32x4 w4 = *(const f32x4*)(wi + (size_t)kk * D + c); a[kk] += (w4[0] * wv[0] + w4[1] * wv[1]) + (w4[2] * wv[2] + w4[3] * wv[3]); }
            }
            const float ps = pool_scale[d];
            const f32x4 g0 = *(const f32x4*)(mix_norm + k0), g1 = *(const f32x4*)(mix_norm + k0 + 4);
            v4u o; o.x = cvt_pk_bf16(a[0] * ps * g0[0], a[1] * ps * g0[1]); o.y = cvt_pk_bf16(a[2] * ps * g0[2], a[3] * ps * g0[3]);
            o.z = cvt_pk_bf16(a[4] * ps * g1[0], a[5] * ps * g1[1]); o.w = cvt_pk_bf16(a[6] * ps * g1[2], a[7] * ps * g1[3]);
            *(v4u*)(WIN + (size_t)(512 + d) * D + k0) = o;
        }
        {
            constexpr int I_FF = (D / 64) * (FF / 32);
            constexpr int I_W2 = (FF / 64) * (D / 32);
            constexpr int I_SQ = (D / 64) * (D / 32);
            constexpr int I_IN = (D / 64) * (SW / 32);
            constexpr int I_GL = (SW / 64) * (SW / 32);
            constexpr int I_PP = (PLE / 64) * (D / 32);
            constexpr int NIT = 4 * I_FF + 2 * I_W2 + 2 * I_SQ + I_IN + I_GL + I_PP;
            for (int it = gw; it < NIT; it += NGW) {
                int r = it;
                if (r < 4 * I_FF) { const int which = r / I_FF; r -= which * I_FF; const int nb = FF / 32, kb = r / nb, n0 = (r % nb) * 32;
                    const float* W = which == 0 ? ffn1_w1 : which == 1 ? ffn1_w3 : which == 2 ? ffn2_w1 : ffn2_w3; bf16* WT = which < 2 ? W13A : W13B;
                    const int drow0 = (n0 >> 7) * 256 + (n0 & 127) + (which & 1) * 128;
                    transpose_item(W, D, FF, WT, kb * 64, n0, drow0, which < 2 ? ffn1_norm : ffn2_norm, 1.0f, scr, lane); continue; }
                r -= 4 * I_FF;
                if (r < 2 * I_W2) { const int which = r / I_W2; r -= which * I_W2; const int nb = D / 32, kb = r / nb, n0 = (r % nb) * 32;
                    transpose_item(which ? ffn2_w2 : ffn1_w2, FF, D, which ? W2B : W2A, kb * 64, n0, n0, nullptr, 0.5f, scr, lane); continue; }
                r -= 2 * I_W2;
                if (r < 2 * I_SQ) { const int which = r / I_SQ; r -= which * I_SQ; const int nb = D / 32, kb = r / nb, n0 = (r % nb) * 32;
                    if (which == 0) { const float* gn = (kb * 64 < SW) ? ssm_out_norm + kb * 64 : pool_out_norm + (kb * 64 - SW);
                        transpose_item(w_out, D, D, WO, kb * 64, n0, n0, gn - kb * 64, 1.0f, scr, lane); }
                    else transpose_item(w_ple_gate, D, D, WG, kb * 64, n0, n0, ple_gate_norm, 1.0f, scr, lane);
                    continue; }
                r -= 2 * I_SQ;
                if (r < I_IN) { const int nb = SW / 32, kb = r / nb, n0 = (r % nb) * 32; transpose_item(w_in, D, D, WIN, kb * 64, n0, n0, mix_norm, 1.0f, scr, lane); continue; }
                r -= I_IN;
                if (r < I_GL) { const int nb = SW / 32, kb = r / nb, n0 = (r % nb) * 32; transpose_item(w_glu, SW, SW, WGLU, kb * 64, n0, n0, nullptr, 1.0f, scr, lane); continue; }
                r -= I_GL;
                { const int nb = D / 32, kb = r / nb, n0 = (r % nb) * 32; transpose_item(w_ple_proj, PLE, D, WPP, kb * 64, n0, n0, nullptr, 1.0f, scr, lane); }
            }
        }
        for (int r0 = 2 * gw; r0 < M; r0 += 2 * NGW) {
            f32x4 v[2][4]; f32x4 pv[2]; float s[2];
#pragma unroll
            for (int h = 0; h < 2; ++h) { const f32x4* xr = (const f32x4*)(x + (size_t)(r0 + h) * D) + lane;
#pragma unroll
                for (int j = 0; j < 4; ++j) v[h][j] = xr[64 * j];
                pv[h] = *((const f32x4*)(pin + (size_t)(r0 + h) * PLE) + lane); }
#pragma unroll
            for (int h = 0; h < 2; ++h) { s[h] = 0.f;
#pragma unroll
                for (int j = 0; j < 4; ++j) s[h] += (v[h][j][0] * v[h][j][0] + v[h][j][1] * v[h][j][1]) + (v[h][j][2] * v[h][j][2] + v[h][j][3] * v[h][j][3]); }
            s[0] = wave_sum(s[0]); s[1] = wave_sum(s[1]);
            if (lane < 2) SS0[r0 + lane] = lane ? s[1] : s[0];
#pragma unroll
            for (int h = 0; h < 2; ++h) { v2u* o8 = (v2u*)(HB + (size_t)(r0 + h) * D) + lane;
#pragma unroll
                for (int j = 0; j < 4; ++j) { v2u w; w.x = cvt_pk_bf16(v[h][j][0], v[h][j][1]); w.y = cvt_pk_bf16(v[h][j][2], v[h][j][3]); o8[64 * j] = w; }
                v2u w; w.x = cvt_pk_bf16(pv[h][0], pv[h][1]); w.y = cvt_pk_bf16(pv[h][2], pv[h][3]); *((v2u*)(PB + (size_t)(r0 + h) * PLE) + lane) = w; }
        }
    }
    SEAM(0);

    if (IN(1)) {
        { pg8::Gemm g{PB, WPP, PLE, PLE, PLE}; pg8::StaticOrder S; S.init(M, D, G, bx); pg8::EpiEmb E{EB, SSE};
          pg8::gemm_phase<pg8::EpiEmb, pg8::StaticOrder, true>(lds + RING_OFF, g, S, E); }
        { pg8::Gemm g{HB, W13A, D, D, D}; pg8::StaticOrder S; S.init(M, NFF2, G, bx); pg8::EpiSwiGLU<1> E{ACT, FF, SS0, 1.0f / 1024.0f};
          pg8::gemm_phase<pg8::EpiSwiGLU<1>, pg8::StaticOrder, true>(lds + RING_OFF, g, S, E); }
    }
    SEAM(1);
    if (IN(2)) {
        pg8::Gemm g{ACT, W2A, FF, FF, FF}; pg8::StaticOrder S; S.init(M, D, G, bx); pg8::EpiResid<false> E{HB, SS1, nullptr, 0.f};
        pg8::gemm_phase<pg8::EpiResid<false>, pg8::StaticOrder, true>(lds + RING_OFF, g, S, E);
    }
    SEAM(2);
    if (IN(3)) {
        pg8::Gemm g{HB, WIN, D, D, D}; pg8::StaticOrder S; S.init(M, D, G, bx); pg8::EpiWin E{AEXT, QB, SS1};
        pg8::gemm_phase<pg8::EpiWin, pg8::StaticOrder, true>(lds + RING_OFF, g, S, E);
    }
    SEAM(3);
    if (IN(4)) {
#ifndef PROBE_SUB
#define PROBE_SUB 0
#endif
        for (int rep_ = 0; rep_ < (PROBE_SUB == 2 ? 2 : 1); ++rep_)
        for (int unit = bx; unit < 256; unit += G) {
            const int g_ = unit >> 3;
            { pg8::Gemm g{AEXT + 128, S5WE, 384, 256, 256}; pg8::SingleUnit S{unit, g_}; pg8::EpiS5End E{};
              pg8::gemm_phase<pg8::EpiS5End, pg8::SingleUnit, false>(lds + RING_OFF, g, S, E); }
            LDS_WAIT(); __syncthreads();
            for (int rep2_ = 0; rep2_ < (PROBE_SUB == 3 ? 2 : 1); ++rep2_)
            if (wave == 0) {
                const LAS float* El = (const LAS float*)(lds + RING_OFF);
                const float ar = A16[(g_ * NS + lane) * 2], ai = A16[(g_ * NS + lane) * 2 + 1];
                float cr = 0.f, ci = 0.f;
                bf16* dst = AEXT + (size_t)unit * 256 * 384 + lane;
#pragma unroll 1
                for (int c0 = 0; c0 < 256; c0 += 8) {
                    float er[8], ei[8];
#pragma unroll
                    for (int i = 0; i < 8; ++i) { er[i] = El[(c0 + i) * 128 + lane]; ei[i] = El[(c0 + i) * 128 + 64 + lane]; }
#pragma unroll
                    for (int i = 0; i < 8; ++i) {
                        dst[(size_t)(c0 + i) * 384] = f2bf(cr); dst[(size_t)(c0 + i) * 384 + 64] = f2bf(ci);
                        const float nr = ar * cr - ai * ci + er[i], ni = ar * ci + ai * cr + ei[i]; cr = nr; ci = ni;
                    }
                }
#if PROBE_SUB == 5
                __threadfence();
#endif
            }
            VM_WAIT(); __syncthreads();
            { pg8::Gemm g{AEXT, S5BT, 384, 384, 384}; pg8::SingleUnit S{unit, g_}; pg8::EpiS5Out E{AEXT, YACT, d_skip};
              pg8::gemm_phase<pg8::EpiS5Out, pg8::SingleUnit, false>(lds + RING_OFF, g, S, E); }
        }
        for (int rep_ = 0; rep_ < (PROBE_SUB == 1 ? 2 : 1); ++rep_)
        for (int blk = gw; blk < M / 16; blk += NGW) {
            const int w = 2 << (lane >> 4), r0 = blk * 16, l0 = r0 & (SEQ - 1);
            const bf16* qb = QB + (size_t)r0 * 512 + 8 * lane;
            float S[8];
#pragma unroll
            for (int e = 0; e < 8; ++e) S[e] = 0.f;
            if (l0 > 0) {
#pragma unroll
                for (int jj = 1; jj <= 16; ++jj) if (jj <= w) { const v4u qw = *(const v4u*)(qb - (ptrdiff_t)jj * 512);
                    S[0] += pg8::bf_lo(qw.x); S[1] += pg8::bf_hi(qw.x); S[2] += pg8::bf_lo(qw.y); S[3] += pg8::bf_hi(qw.y); S[4] += pg8::bf_lo(qw.z); S[5] += pg8::bf_hi(qw.z); S[6] += pg8::bf_lo(qw.w); S[7] += pg8::bf_hi(qw.w); }
            }
#pragma unroll
            for (int hh = 0; hh < 2; ++hh) {
                v4u cur[8], old[8];
#pragma unroll
                for (int i = 0; i < 8; ++i) { const int rr = hh * 8 + i; cur[i] = *(const v4u*)(qb + (size_t)rr * 512);
                    old[i] = (v4u){0u, 0u, 0u, 0u}; if (l0 + rr >= w) old[i] = *(const v4u*)(qb + ((ptrdiff_t)rr - w) * 512); }
                float pl[8][8], qs[8];
#pragma unroll
                for (int i = 0; i < 8; ++i) { const int rr = hh * 8 + i, l = l0 + rr; const int cnt = (l + 1) < w ? (l + 1) : w; const float ic = 1.0f / (float)cnt;
                    float f[8], o[8];
                    f[0] = pg8::bf_lo(cur[i].x); f[1] = pg8::bf_hi(cur[i].x); f[2] = pg8::bf_lo(cur[i].y); f[3] = pg8::bf_hi(cur[i].y); f[4] = pg8::bf_lo(cur[i].z); f[5] = pg8::bf_hi(cur[i].z); f[6] = pg8::bf_lo(cur[i].w); f[7] = pg8::bf_hi(cur[i].w);
                    o[0] = pg8::bf_lo(old[i].x); o[1] = pg8::bf_hi(old[i].x); o[2] = pg8::bf_lo(old[i].y); o[3] = pg8::bf_hi(old[i].y); o[4] = pg8::bf_lo(old[i].z); o[5] = pg8::bf_hi(old[i].z); o[6] = pg8::bf_lo(old[i].w); o[7] = pg8::bf_hi(old[i].w);
                    float q = 0.f;
#pragma unroll
                    for (int e = 0; e < 8; ++e) { S[e] += f[e] - o[e]; pl[i][e] = S[e] * ic - f[e]; q += pl[i][e] * pl[i][e]; }
                    qs[i] = q; }
#pragma unroll
                for (int i = 0; i < 8; ++i) qs[i] = wave_sum(qs[i]);
#pragma unroll
                for (int i = 0; i < 8; ++i) { const int rr = hh * 8 + i; const float rs = rsqrtf(qs[i] * (1.0f / 512.0f) + pg8::RMS_EPS);
                    v4u o; o.x = cvt_pk_bf16(pl[i][0] * rs, pl[i][1] * rs); o.y = cvt_pk_bf16(pl[i][2] * rs, pl[i][3] * rs); o.z = cvt_pk_bf16(pl[i][4] * rs, pl[i][5] * rs); o.w = cvt_pk_bf16(pl[i][6] * rs, pl[i][7] * rs);
                    *(v4u*)(A5 + (size_t)(r0 + rr) * 1024 + 512 + 8 * lane) = o; }
            }
        }
    }
    SEAM(4);
    if (IN(5)) {
        pg8::Gemm g{YACT, WGLU, SW, SW, SW}; pg8::StaticOrder S; S.init(M, SW, G, bx); pg8::EpiGlu E{YACT, A5, b_glu, SSS};
        pg8::gemm_phase<pg8::EpiGlu, pg8::StaticOrder, true>(lds + RING_OFF, g, S, E);
    }
    SEAM(5);
    if (IN(6)) {
        pg8::Gemm g{A5, WO, D, D, D}; pg8::StaticOrder S; S.init(M, D, G, bx); pg8::EpiResid<true> E{HB, SS2, SSS, 1.0f / 512.0f};
        pg8::gemm_phase<pg8::EpiResid<true>, pg8::StaticOrder, true>(lds + RING_OFF, g, S, E);
    }
    SEAM(6);
    if (IN(7)) {
        pg8::Gemm g{HB, W13B, D, D, D}; pg8::StaticOrder S; S.init(M, NFF2, G, bx); pg8::EpiSwiGLU<16> E{ACT, FF, SS2, 1.0f / 1024.0f};
        pg8::gemm_phase<pg8::EpiSwiGLU<16>, pg8::StaticOrder, true>(lds + RING_OFF, g, S, E);
    }
    SEAM(7);
    if (IN(8)) {
        pg8::Gemm g{ACT, W2B, FF, FF, FF}; pg8::StaticOrder S; S.init(M, D, G, bx); pg8::EpiResid<false> E{HB, SS3, nullptr, 0.f};
        pg8::gemm_phase<pg8::EpiResid<false>, pg8::StaticOrder, true>(lds + RING_OFF, g, S, E);
    }
    SEAM(8);
    if (IN(9)) {
        pg8::Gemm g{HB, WG, D, D, D}; pg8::StaticOrder S; S.init(M, D, G, bx); pg8::EpiGate E{out, HB, EB, SS3, SSE, ple_norm, SS4};
        pg8::gemm_phase<pg8::EpiGate, pg8::StaticOrder, true>(lds + RING_OFF, g, S, E);
    }
    SEAM(9);
    if (IN(10)) {
        for (int r = gw; r < M; r += NGW) {
            const float rs = pg8::row_rstd<16>(SS4, r, 1.0f / 1024.0f);
            f32x4* o = (f32x4*)(out + (size_t)r * D) + lane; const f32x4* gn = (const f32x4*)final_norm + lane;
#pragma unroll
            for (int j = 0; j < 4; ++j) { f32x4 v = o[64 * j]; const f32x4 gg = gn[64 * j]; v = v * rs * gg; o[64 * j] = v; }
        }
    }
#undef IN
#undef SEAM
}

extern "C" void kernel_launch(void* const* d_in, const int* in_sizes, int n_in, void* d_out, int out_size, void* d_ws, size_t ws_size, hipStream_t stream) {
    static int grid = 0;
    if (grid == 0) {
        if (n_in != 32 || in_sizes[0] != M * D || out_size != M * D || ws_size < WS_END) { fprintf(stderr, "kernel_launch: unexpected shapes (n_in %d, in0 %d, out %d, ws %zu)\n", n_in, n_in > 0 ? in_sizes[0] : -1, out_size, ws_size); grid = -1; return; }
        int dev = 0, cus = 0, per_cu = 0;
        if (hipGetDevice(&dev) != hipSuccess || hipDeviceGetAttribute(&cus, hipDeviceAttributeMultiprocessorCount, dev) != hipSuccess) { grid = -1; return; }
        if (hipFuncSetAttribute((const void*)hymba_fwd, hipFuncAttributeMaxDynamicSharedMemorySize, LDS_BYTES) != hipSuccess) { fprintf(stderr, "kernel_launch: hipFuncSetAttribute failed\n"); grid = -1; return; }
        if (hipOccupancyMaxActiveBlocksPerMultiprocessor(&per_cu, (const void*)hymba_fwd, NWAVES * 64, LDS_BYTES) != hipSuccess || per_cu < 1)
            fprintf(stderr, "kernel_launch: occupancy query reports %d workgroups per CU\n", per_cu);
        (void)hipGetLastError();
        grid = cus;
    }
    if (grid < 0) return;
    if (hipMemsetAsync((char*)d_ws + WS_CTL, 0, CTL_ZERO_BYTES, stream) != hipSuccess) { fprintf(stderr, "kernel_launch: memset failed\n"); return; }
    Args a{};
    for (int i = 0; i < 32; ++i) a.in[i] = (const float*)d_in[i];
    a.out = (float*)d_out; a.ws = (unsigned char*)d_ws;
#if defined(PROBE_PHASE)
    {
        const int k = PROBE_PHASE; const int los[3] = {0, k, k + 1}, his[3] = {k + 1, k + 1, NPHASE};
        for (int li = 0; li < 3; ++li) { if (los[li] >= his[li]) continue; a.ph_lo = los[li]; a.ph_hi = his[li]; a.li = li; hipLaunchKernelGGL(hymba_fwd, dim3(grid), dim3(NWAVES * 64), LDS_BYTES, stream, a); }
    }
#else
    if (N_LAUNCHES == 1) { a.ph_lo = 0; a.ph_hi = NPHASE; a.li = 0; hipLaunchKernelGGL(hymba_fwd, dim3(grid), dim3(NWAVES * 64), LDS_BYTES, stream, a); }
    else for (int li = 0; li < NPHASE; ++li) { a.ph_lo = li; a.ph_hi = li + 1; a.li = 0; hipLaunchKernelGGL(hymba_fwd, dim3(grid), dim3(NWAVES * 64), LDS_BYTES, stream, a); }
#endif
    const hipError_t le = hipPeekAtLastError();
    if (le != hipSuccess) fprintf(stderr, "kernel_launch: launch failed: %s\n", hipGetErrorName(le));
}
```
